# Optimizing an MI355X kernel written in HIP

```python
import math
import jax
import jax.numpy as jnp
from jax import lax
import numpy as np

D_MODEL = 2048
BATCH = 16
SEQ = 256
DEPTH = 4
DEC_BATCH = 2
DEC_SEQ = 2048
PAST_LEN = 256

GRID_W = 64
HEAD_DIM = 64
GROUP_WIDTH = D_MODEL // 4
MIX_WIDTH = 4 * GROUP_WIDTH
NA_HEADS = GROUP_WIDTH // HEAD_DIM
NA_WIN_R = 8
NA_WIN_C = 16
NA_COL_BLOCK = 16
NA_COL_BAND = NA_COL_BLOCK + NA_WIN_C
CONV_CH = GROUP_WIDTH
CONV_K = 3
SWA_HEADS = GROUP_WIDTH // HEAD_DIM
SWA_KV_HEADS = 2
SWA_GROUP = SWA_HEADS // SWA_KV_HEADS
SWA_WINDOW = 128
SWA_BLOCK = 128
DIFF_HEADS = GROUP_WIDTH // (2 * HEAD_DIM)
DIFF_V = 2 * HEAD_DIM
DIFF_BLOCK = 128
MLP_HIDDEN = 4 * D_MODEL
N_MOD = 6
ROPE_BASE = 10000.0
RMS_EPS = 1e-6
NEG_INF = -1e30
SCALE = HEAD_DIM ** -0.5
IN_SIZES = (GROUP_WIDTH, GROUP_WIDTH, GROUP_WIDTH,
            CONV_CH, CONV_CH, CONV_CH,
            SWA_HEADS * HEAD_DIM, SWA_KV_HEADS * HEAD_DIM, SWA_KV_HEADS * HEAD_DIM,
            DIFF_HEADS * 2 * HEAD_DIM, DIFF_HEADS * 2 * HEAD_DIM, DIFF_HEADS * DIFF_V)
IN_COLS = sum(IN_SIZES)

kernel_name = 'hybrid_diffusion_prefix_trunk'


def rmsnorm(x, g):
    xf = x.astype(jnp.float32)
    y = xf * lax.rsqrt(jnp.mean(xf * xf, axis=-1, keepdims=True) + RMS_EPS)
    return (y * g.astype(jnp.float32)).astype(x.dtype)


def heads(t, h):
    return t.reshape(t.shape[:-1] + (h, t.shape[-1] // h))


def split_proj(p):
    out, off = [], 0
    for n in IN_SIZES:
        out.append(p[..., off:off + n])
        off += n
    return out


def modulation(cvec, w, b):
    m = jax.nn.silu(cvec) @ w + b
    return m.reshape(m.shape[:-1] + (N_MOD, D_MODEL))


def mod_term(m, i):
    return m[..., i, :][..., None, :]


def pre_mix(x, m, g):
    return rmsnorm(x, g[0]) * (1 + mod_term(m, 1)) + mod_term(m, 0)


def post_layer(x, mix, m, g, w_out, w1, w2):
    x = x + mod_term(m, 2) * rmsnorm(mix @ w_out, g[1])
    h = rmsnorm(x, g[2]) * (1 + mod_term(m, 4)) + mod_term(m, 3)
    f = jnp.square(jax.nn.relu(h @ w1)) @ w2
    return x + mod_term(m, 5) * rmsnorm(f, g[3])


def axial_angles(T):
    t = jnp.arange(T)
    rows = (t // GRID_W).astype(jnp.float32)
    cols = (t % GRID_W).astype(jnp.float32)
    n = HEAD_DIM // 4
    inv = ROPE_BASE ** (-jnp.arange(n, dtype=jnp.float32) / n)
    return rows[:, None] * inv[None], cols[:, None] * inv[None]


def _rotate(x, ang):
    n = ang.shape[-1]
    cos = jnp.cos(ang)[None, :, None, :].astype(x.dtype)
    sin = jnp.sin(ang)[None, :, None, :].astype(x.dtype)
    x1, x2 = x[..., :n], x[..., n:]
    return jnp.concatenate([x1 * cos - x2 * sin, x1 * sin + x2 * cos], axis=-1)


def rope_2d(x, ang_r, ang_c):
    h = x.shape[-1] // 2
    return jnp.concatenate([_rotate(x[..., :h], ang_r), _rotate(x[..., h:], ang_c)], axis=-1)


def conv_mixer(u, gb, gc, w):
    z = gc * u
    T = z.shape[1]
    zp = jnp.pad(z, ((0, 0), (1, 1), (0, 0)))
    conv = zp[:, :T] * w[0] + zp[:, 1:T + 1] * w[1] + zp[:, 2:] * w[2]
    return gb * conv


def sink_softmax(s, sink):
    m = jnp.maximum(jnp.max(s, axis=-1, keepdims=True), sink)
    e = jnp.exp(s - m)
    return e / (jnp.sum(e, axis=-1, keepdims=True) + jnp.exp(sink - m))


def ctx_mha(q, k, v):
    s = jnp.einsum('bqhd,bkhd->bhqk', q, k).astype(jnp.float32) * SCALE
    p = jax.nn.softmax(s, axis=-1).astype(v.dtype)
    o = jnp.einsum('bhqk,bkhd->bqhd', p, v)
    return o.reshape(o.shape[:2] + (-1,))


def ctx_gqa_sink(q, k, v, sink):
    B, S = q.shape[:2]
    qg = q.reshape(B, S, SWA_KV_HEADS, SWA_GROUP, HEAD_DIM)
    s = jnp.einsum('bqngd,bknd->bngqk', qg, k).astype(jnp.float32) * SCALE
    sk = sink.astype(jnp.float32).reshape(SWA_KV_HEADS, SWA_GROUP)[None, :, :, None, None]
    p = sink_softmax(s, sk).astype(v.dtype)
    o = jnp.einsum('bngqk,bknd->bqngd', p, v)
    return o.reshape(B, S, SWA_HEADS * HEAD_DIM)


def lambda_value(lam_p, lam_init):
    lp = lam_p.astype(jnp.float32)
    return jnp.exp(jnp.sum(lp[0] * lp[1])) - jnp.exp(jnp.sum(lp[2] * lp[3])) + lam_init


def diff_combine(q1, q2, k1, k2, v, lam):
    a1 = jax.nn.softmax(jnp.einsum('bqhd,bkhd->bhqk', q1, k1).astype(jnp.float32) * SCALE, axis=-1)
    a2 = jax.nn.softmax(jnp.einsum('bqhd,bkhd->bhqk', q2, k2).astype(jnp.float32) * SCALE, axis=-1)
    return jnp.einsum('bhqk,bkhe->bqhe', (a1 - lam * a2).astype(v.dtype), v)


def diff_finish(o, g, lam_init):
    o = rmsnorm(o, g) * (1.0 - lam_init)
    return o.reshape(o.shape[:2] + (DIFF_HEADS * DIFF_V,))


def neighbourhood_attention(q, k, v, k_ctx, v_ctx, rpb):
    B, T, H, d = q.shape
    rows = T // GRID_W
    kr = min(NA_WIN_R, rows)
    ncb = GRID_W // NA_COL_BLOCK
    r = jnp.arange(rows)
    row_idx = jnp.clip(r - kr // 2, 0, rows - kr)[:, None] + jnp.arange(kr)[None]
    cb = jnp.arange(ncb)
    band = jnp.clip(cb * NA_COL_BLOCK - NA_WIN_C // 2, 0, GRID_W - NA_COL_BAND)
    col_idx = band[:, None] + jnp.arange(NA_COL_BAND)[None]
    qc = cb[:, None] * NA_COL_BLOCK + jnp.arange(NA_COL_BLOCK)[None]
    cs = jnp.clip(qc - NA_WIN_C // 2, 0, GRID_W - NA_WIN_C)
    kc = col_idx[:, None, :]
    col_ok = (kc >= cs[..., None]) & (kc < cs[..., None] + NA_WIN_C)
    kloc = kr * NA_COL_BAND
    mask = jnp.broadcast_to(col_ok[:, :, None, :], (ncb, NA_COL_BLOCK, kr, NA_COL_BAND)).reshape(ncb, NA_COL_BLOCK, kloc)
    ri = row_idx[:, None, :, None]
    ci = col_idx[None, :, None, :]
    k_blk = k.reshape(B, rows, GRID_W, H, d)[:, ri, ci].reshape(B, rows, ncb, kloc, H, d)
    v_blk = v.reshape(B, rows, GRID_W, H, d)[:, ri, ci].reshape(B, rows, ncb, kloc, H, d)
    q_blk = q.reshape(B, rows, ncb, NA_COL_BLOCK, H, d)
    dr = row_idx - r[:, None] + NA_WIN_R - 1
    dc = jnp.clip(kc - qc[..., None], -(NA_WIN_C - 1), NA_WIN_C - 1) + NA_WIN_C - 1
    bias = rpb[:, dr[:, None, None, :, None], dc[None, :, :, None, :]]
    bias = bias.reshape(H, rows, ncb, NA_COL_BLOCK, kloc).astype(jnp.float32)
    s_loc = jnp.einsum('brcqhd,brckhd->bhrcqk', q_blk, k_blk).astype(jnp.float32) * SCALE + bias[None]
    s_loc = jnp.where(mask[None, None, None], s_loc, NEG_INF)
    s_ctx = jnp.einsum('brcqhd,bkhd->bhrcqk', q_blk, k_ctx).astype(jnp.float32) * SCALE
    p = jax.nn.softmax(jnp.concatenate([s_loc, s_ctx], axis=-1), axis=-1).astype(v.dtype)
    o = (jnp.einsum('bhrcqk,brckhd->brcqhd', p[..., :kloc], v_blk)
         + jnp.einsum('bhrcqk,bkhd->brcqhd', p[..., kloc:], v_ctx))
    return o.reshape(B, T, H * d)


def window_gqa_sink(q, k, v, k_ctx, v_ctx, sink):
    B, T, H, d = q.shape
    nb = T // SWA_BLOCK
    bw = SWA_BLOCK + 2 * SWA_WINDOW
    pad = ((0, 0), (SWA_WINDOW, SWA_WINDOW), (0, 0), (0, 0))
    idx = jnp.arange(nb)[:, None] * SWA_BLOCK + jnp.arange(bw)[None]
    k_blk = jnp.pad(k, pad)[:, idx]
    v_blk = jnp.pad(v, pad)[:, idx]
    qpos = jnp.arange(nb)[:, None] * SWA_BLOCK + jnp.arange(SWA_BLOCK)[None]
    kpos = idx - SWA_WINDOW
    valid = ((jnp.abs(qpos[:, :, None] - kpos[:, None, :]) <= SWA_WINDOW)
             & (kpos[:, None, :] >= 0) & (kpos[:, None, :] < T))
    qb = q.reshape(B, nb, SWA_BLOCK, SWA_KV_HEADS, SWA_GROUP, d)
    s_loc = jnp.einsum('bnqhgd,bnjhd->bhgnqj', qb, k_blk).astype(jnp.float32) * SCALE
    s_loc = jnp.where(valid[None, None, None], s_loc, NEG_INF)
    s_ctx = jnp.einsum('bnqhgd,bjhd->bhgnqj', qb, k_ctx).astype(jnp.float32) * SCALE
    sk = sink.astype(jnp.float32).reshape(SWA_KV_HEADS, SWA_GROUP)[None, :, :, None, None, None]
    p = sink_softmax(jnp.concatenate([s_loc, s_ctx], axis=-1), sk).astype(v.dtype)
    o = (jnp.einsum('bhgnqj,bnjhd->bnqhgd', p[..., :bw], v_blk)
         + jnp.einsum('bhgnqj,bjhd->bnqhgd', p[..., bw:], v_ctx))
    return o.reshape(B, T, H * d)


def diff_attention_latent(q1, q2, k1, k2, v, k1c, k2c, vc, lam):
    B, T, H, d = q1.shape
    nb = T // DIFF_BLOCK
    K1 = jnp.concatenate([k1, k1c], axis=1)
    K2 = jnp.concatenate([k2, k2c], axis=1)
    V = jnp.concatenate([v, vc], axis=1)
    qb = jnp.stack([q1, q2]).reshape(2, B, nb, DIFF_BLOCK, H, d).transpose(2, 0, 1, 3, 4, 5)
    o = lax.map(lambda qs: diff_combine(qs[0], qs[1], K1, K2, V, lam), qb)
    return o.transpose(1, 0, 2, 3, 4).reshape(B, T, H, DIFF_V)


def context_mixer(p, conv_w, sink, lam, lam_init, dg):
    B, S, _ = p.shape
    na_q, na_k, na_v, u, gb, gc, sq, sk, sv, dq, dk, dv = split_proj(p)
    na_q, na_k, na_v = heads(na_q, NA_HEADS), heads(na_k, NA_HEADS), heads(na_v, NA_HEADS)
    o_a = ctx_mha(na_q, na_k, na_v)
    o_b = conv_mixer(u, gb, gc, conv_w)
    sq, sk, sv = heads(sq, SWA_HEADS), heads(sk, SWA_KV_HEADS), heads(sv, SWA_KV_HEADS)
    o_c = ctx_gqa_sink(sq, sk, sv, sink)
    dq, dk, dv = heads(dq, DIFF_HEADS), heads(dk, DIFF_HEADS), heads(dv, DIFF_HEADS)
    o_d = diff_finish(diff_combine(dq[..., :HEAD_DIM], dq[..., HEAD_DIM:], dk[..., :HEAD_DIM], dk[..., HEAD_DIM:], dv, lam), dg, lam_init)
    mix = jnp.concatenate([o_a, o_b, o_c, o_d], axis=-1)
    return mix, jnp.stack([na_k, na_v], axis=1), jnp.stack([sk, sv], axis=1), jnp.stack([dk, dv], axis=1)


def latent_mixer(p, na_kv, swa_kv, diff_kv, conv_w, rpb, sink, lam, lam_init, dg, ang_r, ang_c):
    na_q, na_k, na_v, u, gb, gc, sq, sk, sv, dq, dk, dv = split_proj(p)
    na_q, na_k, na_v = heads(na_q, NA_HEADS), heads(na_k, NA_HEADS), heads(na_v, NA_HEADS)
    o_a = neighbourhood_attention(na_q, na_k, na_v, na_kv[:, 0], na_kv[:, 1], rpb)
    o_b = conv_mixer(u, gb, gc, conv_w)
    sq = rope_2d(heads(sq, SWA_HEADS), ang_r, ang_c)
    sk = rope_2d(heads(sk, SWA_KV_HEADS), ang_r, ang_c)
    o_c = window_gqa_sink(sq, sk, heads(sv, SWA_KV_HEADS), swa_kv[:, 0], swa_kv[:, 1], sink)
    dq, dk, dv = heads(dq, DIFF_HEADS), heads(dk, DIFF_HEADS), heads(dv, DIFF_HEADS)
    q1 = rope_2d(dq[..., :HEAD_DIM], ang_r, ang_c)
    q2 = rope_2d(dq[..., HEAD_DIM:], ang_r, ang_c)
    k1 = rope_2d(dk[..., :HEAD_DIM], ang_r, ang_c)
    k2 = rope_2d(dk[..., HEAD_DIM:], ang_r, ang_c)
    kc = diff_kv[:, 0]
    o_d = diff_finish(diff_attention_latent(q1, q2, k1, k2, dv, kc[..., :HEAD_DIM], kc[..., HEAD_DIM:], diff_kv[:, 1], lam), dg, lam_init)
    return jnp.concatenate([o_a, o_b, o_c, o_d], axis=-1)


def setup_inputs(seed: int = 0) -> dict:
    key = jax.random.key(seed)
    ks = jax.random.split(key, 20)
    nrm = jax.random.normal
    f32 = jnp.float32
    return {
        'x_prompt': nrm(ks[0], (BATCH, SEQ, D_MODEL), f32),
        'x_sample': nrm(ks[1], (DEC_BATCH, DEC_SEQ, D_MODEL), f32),
        'cache_na_kv': nrm(ks[2], (DEC_BATCH, DEPTH, 2, PAST_LEN, NA_HEADS, HEAD_DIM), f32),
        'cache_swa_kv': nrm(ks[3], (DEC_BATCH, DEPTH, 2, PAST_LEN, SWA_KV_HEADS, HEAD_DIM), f32),
        'cache_diff_kv': nrm(ks[4], (DEC_BATCH, DEPTH, 2, PAST_LEN, DIFF_HEADS, DIFF_V), f32),
        'c': nrm(ks[5], (DEC_BATCH, D_MODEL), f32),
        'c_ctx': nrm(ks[6], (D_MODEL,), f32),
        'ada_w': nrm(ks[7], (DEPTH, D_MODEL, N_MOD * D_MODEL), f32) * (0.5 * D_MODEL ** -0.5),
        'ada_b': nrm(ks[8], (DEPTH, N_MOD * D_MODEL), f32) * 0.01,
        'norm_g': 1.0 + 0.05 * nrm(ks[9], (DEPTH, 4, D_MODEL), f32),
        'w_in': nrm(ks[10], (DEPTH, D_MODEL, IN_COLS), f32) * D_MODEL ** -0.5,
        'conv_w': nrm(ks[11], (DEPTH, CONV_K, CONV_CH), f32) * CONV_K ** -0.5,
        'na_rpb': nrm(ks[12], (DEPTH, NA_HEADS, 2 * NA_WIN_R - 1, 2 * NA_WIN_C - 1), f32) * 0.1,
        'swa_sink': nrm(ks[13], (DEPTH, SWA_HEADS), f32),
        'diff_lambda': nrm(ks[14], (DEPTH, 4, HEAD_DIM), f32) * 0.1,
        'diff_norm_g': 1.0 + 0.05 * nrm(ks[15], (DEPTH, DIFF_V), f32),
        'w_out': nrm(ks[16], (DEPTH, MIX_WIDTH, D_MODEL), f32) * MIX_WIDTH ** -0.5,
        'mlp_w1': nrm(ks[17], (DEPTH, D_MODEL, MLP_HIDDEN), f32) * D_MODEL ** -0.5,
        'mlp_w2': nrm(ks[18], (DEPTH, MLP_HIDDEN, D_MODEL), f32) * MLP_HIDDEN ** -0.5,
    }


def reference(x_prompt, x_sample, cache_na_kv, cache_swa_kv, cache_diff_kv, c, c_ctx,
              ada_w, ada_b, norm_g, w_in, conv_w, na_rpb, swa_sink, diff_lambda, diff_norm_g,
              w_out, mlp_w1, mlp_w2):
    ang_r, ang_c = axial_angles(x_sample.shape[1])
    yp, ys = x_prompt, x_sample
    na_st, swa_st, diff_st = [], [], []
    for l in range(DEPTH):
        lam_init = 0.8 - 0.6 * math.exp(-0.3 * l)
        lam = lambda_value(diff_lambda[l], lam_init)
        mod_p = modulation(c_ctx, ada_w[l], ada_b[l])
        h = pre_mix(yp, mod_p, norm_g[l])
        mix, na_kv, swa_kv, d_kv = context_mixer(h @ w_in[l], conv_w[l], swa_sink[l], lam, lam_init, diff_norm_g[l])
        yp = post_layer(yp, mix, mod_p, norm_g[l], w_out[l], mlp_w1[l], mlp_w2[l])
        na_st.append(na_kv)
        swa_st.append(swa_kv)
        diff_st.append(d_kv)
        mod_s = modulation(c, ada_w[l], ada_b[l])
        h = pre_mix(ys, mod_s, norm_g[l])
        mix = latent_mixer(h @ w_in[l], cache_na_kv[:, l], cache_swa_kv[:, l], cache_diff_kv[:, l], conv_w[l],
                           na_rpb[l], swa_sink[l], lam, lam_init, diff_norm_g[l], ang_r, ang_c)
        ys = post_layer(ys, mix, mod_s, norm_g[l], w_out[l], mlp_w1[l], mlp_w2[l])
    return (yp, ys, jnp.stack(na_st, axis=1), jnp.stack(swa_st, axis=1), jnp.stack(diff_st, axis=1))
```

```cpp
#include <hip/hip_runtime.h>
#include <cstdio>
#include <cstdint>
#include <cmath>
namespace pg8 {
#define PG8_LAS __attribute__((address_space(3)))
typedef unsigned short bf16_t;
typedef short bf16x8 __attribute__((ext_vector_type(8)));
typedef float f32x4 __attribute__((ext_vector_type(4)));
typedef unsigned u32x4 __attribute__((ext_vector_type(4)));
constexpr int BM = 256, BK = 64, HALF = 128, HTB = HALF * BK * 2  , STAGE_BYTES = 8 * HTB, NXCD = 8, WGM = 8;

__host__ __device__ __forceinline__ int lds_byte(int r, int c) { const int st = (r >> 4) * 2 + (c >> 5), rr = r & 15, cc = c & 31, ob = rr * 64 + cc * 2; return st * 1024 + (ob ^ (((ob >> 9) & 1) << 5)); }
__host__ __device__ __forceinline__ void stage_rc(int b, int& R, int& C) { const int st = b / 1024, sb = b % 1024, swz = sb ^ (((sb >> 9) & 1) << 5); R = (st >> 1) * 16 + swz / 64; C = (st & 1) * 32 + (swz % 64) / 2; }
__host__ __device__ __forceinline__ int perm32(int rho) { const int n = rho >> 4, i = rho & 15; return 8 * (i >> 2) + 4 * n + (i & 3); }

struct Unit { int pm, pn; };
struct Gemm { const bf16_t* A; const bf16_t* Bt; int M, N, K; };

struct StaticOrder {
    int nM, nN, nwg, G, c;
    __host__ __device__ void init(int M, int N, int G_, int c_) { nM = M / BM; nN = N / BM; nwg = nM * nN; G = G_; c = c_; }
    __host__ __device__ bool next(int i, Unit& u) const {
        const long L = (long)i * G + c; if (L >= nwg) return false;
        int wgid = (int)L; { const int q = nwg / NXCD, r = nwg % NXCD, xcd = wgid % NXCD, off = wgid / NXCD; wgid = (xcd < r ? xcd * (q + 1) : r * (q + 1) + (xcd - r) * q) + off; }
        const int nig = WGM * nN, gid = wgid / nig, fm = gid * WGM, gsz = (nM - fm) < WGM ? (nM - fm) : WGM;
        u.pm = fm + ((wgid % nig) % gsz); u.pn = (wgid % nig) / gsz; return true;
    }
    __device__ __forceinline__ void a_ready(const Unit&) const {}
    __device__ __forceinline__ void done(const Unit&) const {}
};

__device__ __forceinline__ unsigned cvt_pk_bf16(float lo, float hi) { unsigned r; asm volatile("v_cvt_pk_bf16_f32 %0, %1, %2" : "=v"(r) : "v"(lo), "v"(hi)); return r; }
typedef float f32x2 __attribute__((ext_vector_type(2)));
template <class Epi, class Sched, bool ALIGN_EPI = false, bool SP2 = false>
__device__ __forceinline__ void gemm_phase(PG8_LAS unsigned char* lds, const Gemm g, const Sched& S, const Epi& E) {
    int tid_l = threadIdx.x; asm volatile("" : "+v"(tid_l));
    const int tid = tid_l, wid = __builtin_amdgcn_readfirstlane(tid >> 6), lane = tid & 63, wr = wid >> 2, wc = wid & 3, fr = lane & 15, fq = lane >> 4;
    const int K = g.K, nt = K / BK;
    unsigned voffA[2], voffB[2];
#pragma unroll
    for (int i = 0; i < 2; ++i) { int R, C; stage_rc(tid * 16 + i * 8192, R, C); const int Rb = Epi::PERM ? ((R & ~31) + perm32(R & 31)) : R;
        voffA[i] = (unsigned)(R * K + C) * 2u; voffB[i] = (unsigned)(Rb * K + C) * 2u; }
    const size_t kstep = (size_t)(BK * 2);
    const size_t hstep = (size_t)HALF * K * 2;
    const size_t tstep = 2 * hstep;
    const unsigned ldsw = (unsigned)wid * 1024u;
    const int aoff = lds_byte(wr * 64 + fr, fq * 8), boff = lds_byte(wc * 32 + fr, fq * 8);
#define PG8_SA(b, h) (((b) * 2 + (h)) * HTB)
#define PG8_SB(b, h) ((4 + (b) * 2 + (h)) * HTB)
#define PG8_STAGE(bufoff, gbase, voff) do { _Pragma("unroll") for (int _i = 0; _i < 2; ++_i) \
        __builtin_amdgcn_global_load_lds((const unsigned*)((const char*)(gbase) + (voff)[_i]), (PG8_LAS unsigned*)(lds + (bufoff) + ldsw + _i * 8192), 16, 0, 0); } while (0)
#define PG8_LDA(dst, b, h) do { _Pragma("unroll") for (int m = 0; m < 4; ++m) _Pragma("unroll") for (int k = 0; k < 2; ++k) dst[m][k] = *(const PG8_LAS bf16x8*)(lds + PG8_SA(b, h) + aoff + m * 2048 + k * 1024); } while (0)
#define PG8_LDB(dst, b, h) do { _Pragma("unroll") for (int n = 0; n < 2; ++n) _Pragma("unroll") for (int k = 0; k < 2; ++k) dst[n][k] = *(const PG8_LAS bf16x8*)(lds + PG8_SB(b, h) + boff + n * 2048 + k * 1024); } while (0)
#define PG8_MMA(ai, bj, At, Bt) do { __builtin_amdgcn_s_setprio(1); _Pragma("unroll") for (int m = 0; m < 4; ++m) _Pragma("unroll") for (int n = 0; n < 2; ++n) _Pragma("unroll") for (int k = 0; k < 2; ++k) \
        acc[ai][bj][m][n] = __builtin_amdgcn_mfma_f32_16x16x32_bf16(Bt[n][k], At[m][k], acc[ai][bj][m][n], 0, 0, 0); __builtin_amdgcn_s_setprio(0); } while (0)
#define PG8_WAIT_V(n) asm volatile("s_waitcnt vmcnt(" #n ")" ::: "memory")
#define PG8_WAIT_L(n) asm volatile("s_waitcnt lgkmcnt(" #n ")" ::: "memory")
#define PG8_BAR __builtin_amdgcn_s_barrier()
#define PG8_SCHED __builtin_amdgcn_sched_barrier(0)
    Unit cur, nxt; int ui = 0;
    if (!S.next(0, cur)) return;
    f32x4 acc[2][2][4][2];
#pragma unroll
    for (int a = 0; a < 2; ++a)
#pragma unroll
        for (int b = 0; b < 2; ++b)
#pragma unroll
            for (int m = 0; m < 4; ++m)
#pragma unroll
                for (int n = 0; n < 2; ++n) acc[a][b][m][n] = (f32x4){0.f, 0.f, 0.f, 0.f};
    bf16x8 At[4][2], B0[2][2], B1[2][2];
    const char* cA = (const char*)g.A + (size_t)cur.pm * tstep; const char* cB = (const char*)g.Bt + (size_t)cur.pn * tstep;
    S.a_ready(cur);
    if constexpr (SP2) {
        PG8_STAGE(PG8_SB(0, 0), cB, voffB); PG8_STAGE(PG8_SB(0, 1), cB + hstep, voffB); PG8_STAGE(PG8_SA(0, 0), cA, voffA); PG8_STAGE(PG8_SA(0, 1), cA + hstep, voffA);
        if (wr == 1) PG8_BAR;
        PG8_WAIT_V(2); PG8_BAR;
        PG8_STAGE(PG8_SB(1, 0), cB + kstep, voffB); PG8_STAGE(PG8_SA(1, 0), cA + kstep, voffA); PG8_STAGE(PG8_SB(1, 1), cB + hstep + kstep, voffB);
        PG8_WAIT_V(6); PG8_BAR;
    } else {
        PG8_STAGE(PG8_SB(0, 0), cB, voffB); PG8_STAGE(PG8_SA(0, 0), cA, voffA); PG8_STAGE(PG8_SB(0, 1), cB + hstep, voffB); PG8_STAGE(PG8_SA(0, 1), cA + hstep, voffA);
        if (wr == 1) PG8_BAR;
        PG8_WAIT_V(4); PG8_BAR;
        PG8_STAGE(PG8_SB(1, 0), cB + kstep, voffB); PG8_STAGE(PG8_SA(1, 0), cA + kstep, voffA); PG8_STAGE(PG8_SB(1, 1), cB + hstep + kstep, voffB);
        PG8_WAIT_V(6); PG8_BAR;
    }
    for (;;) {
        const bool has_next = S.next(ui + 1, nxt);
        const char* nA = has_next ? (const char*)g.A + (size_t)nxt.pm * tstep : cA; const char* nB = has_next ? (const char*)g.Bt + (size_t)nxt.pn * tstep : cB;
        for (int t = 0; t < nt; t += 2) {
            const bool last = (t == nt - 2);
            const char* a1 = cA + (size_t)(t + 1) * kstep;
            const char* a2 = last ? nA : cA + (size_t)(t + 2) * kstep; const char* b2 = last ? nB : cB + (size_t)(t + 2) * kstep;
            const char* a3 = a2 + kstep; const char* b3 = b2 + kstep;
            if (last && has_next) S.a_ready(nxt);
            if constexpr (SP2) {
            PG8_LDB(B0, 0, 0); PG8_LDB(B1, 0, 1); PG8_SCHED; PG8_LDA(At, 0, 0); PG8_STAGE(PG8_SA(1, 1), a1 + hstep, voffA);
            PG8_WAIT_V(8); PG8_WAIT_L(0); PG8_BAR; PG8_MMA(0, 0, At, B0); PG8_MMA(0, 1, At, B1); PG8_BAR; PG8_SCHED;
            PG8_LDA(At, 0, 1); PG8_STAGE(PG8_SB(0, 0), b2, voffB); PG8_STAGE(PG8_SB(0, 1), b2 + hstep, voffB); PG8_STAGE(PG8_SA(0, 0), a2, voffA);
            PG8_WAIT_V(8); PG8_WAIT_L(0); PG8_BAR; PG8_MMA(1, 0, At, B0); PG8_MMA(1, 1, At, B1); PG8_BAR; PG8_SCHED;
            PG8_LDB(B0, 1, 0); PG8_LDB(B1, 1, 1); PG8_SCHED; PG8_LDA(At, 1, 0); PG8_STAGE(PG8_SA(0, 1), a2 + hstep, voffA);
            PG8_WAIT_V(8); PG8_WAIT_L(0); PG8_BAR; PG8_MMA(0, 0, At, B0); PG8_MMA(0, 1, At, B1); PG8_BAR; PG8_SCHED;
            PG8_LDA(At, 1, 1); PG8_STAGE(PG8_SB(1, 0), b3, voffB); PG8_STAGE(PG8_SB(1, 1), b3 + hstep, voffB); PG8_STAGE(PG8_SA(1, 0), a3, voffA);
            PG8_WAIT_V(8); PG8_WAIT_L(0); PG8_BAR; PG8_MMA(1, 0, At, B0); PG8_MMA(1, 1, At, B1); PG8_BAR; PG8_SCHED;
            } else {
            PG8_LDB(B0, 0, 0); PG8_SCHED; PG8_LDA(At, 0, 0); PG8_STAGE(PG8_SA(1, 1), a1 + hstep, voffA);
            PG8_WAIT_L(8); PG8_BAR; PG8_WAIT_L(0); PG8_MMA(0, 0, At, B0); PG8_BAR; PG8_SCHED;
            PG8_LDB(B1, 0, 1); PG8_STAGE(PG8_SB(0, 0), b2, voffB);
            PG8_BAR; PG8_WAIT_L(0); PG8_MMA(0, 1, At, B1); PG8_BAR;
            PG8_LDA(At, 0, 1); PG8_STAGE(PG8_SA(0, 0), a2, voffA);
            PG8_BAR; PG8_WAIT_L(0); PG8_MMA(1, 0, At, B0); PG8_BAR; PG8_SCHED;
            PG8_STAGE(PG8_SB(0, 1), b2 + hstep, voffB);
            PG8_WAIT_V(6); PG8_BAR; PG8_MMA(1, 1, At, B1); PG8_BAR;
            PG8_LDB(B0, 1, 0); PG8_SCHED; PG8_LDA(At, 1, 0); PG8_STAGE(PG8_SA(0, 1), a2 + hstep, voffA);
            PG8_WAIT_L(8); PG8_BAR; PG8_WAIT_L(0); PG8_MMA(0, 0, At, B0); PG8_BAR; PG8_SCHED;
            PG8_LDB(B1, 1, 1); PG8_STAGE(PG8_SB(1, 0), b3, voffB);
            PG8_BAR; PG8_WAIT_L(0); PG8_MMA(0, 1, At, B1); PG8_BAR;
            PG8_LDA(At, 1, 1); PG8_STAGE(PG8_SA(1, 0), a3, voffA);
            PG8_BAR; PG8_WAIT_L(0); PG8_MMA(1, 0, At, B0); PG8_BAR; PG8_SCHED;
            PG8_STAGE(PG8_SB(1, 1), b3 + hstep, voffB);
            PG8_WAIT_V(6); PG8_BAR; PG8_MMA(1, 1, At, B1); PG8_BAR;
            }
        }
        if constexpr (ALIGN_EPI) { if (wr == 0) PG8_BAR; }
        if constexpr (!Epi::AFTER_DRAIN) { E(acc, cur, wr, wc, fr, fq); S.done(cur); }
        if (!has_next) break;
#pragma unroll
        for (int a = 0; a < 2; ++a)
#pragma unroll
            for (int b = 0; b < 2; ++b)
#pragma unroll
                for (int m = 0; m < 4; ++m)
#pragma unroll
                    for (int n = 0; n < 2; ++n) acc[a][b][m][n] = (f32x4){0.f, 0.f, 0.f, 0.f};
        cur = nxt; cA = nA; cB = nB; ++ui;
        if constexpr (ALIGN_EPI) { if (wr == 1) PG8_BAR; }
    }
    PG8_WAIT_V(0);
    if constexpr (!ALIGN_EPI) { if (wr == 0) PG8_BAR; }
    PG8_BAR;
    if constexpr (Epi::AFTER_DRAIN) { E.fused(acc, cur, wr, wc, fr, fq, lds, wid, lane); S.done(cur); }
#undef PG8_SA
#undef PG8_SB
#undef PG8_STAGE
#undef PG8_LDA
#undef PG8_LDB
#undef PG8_MMA
#undef PG8_WAIT_V
#undef PG8_WAIT_L
#undef PG8_BAR
#undef PG8_SCHED
}
}
#define GAS __attribute__((address_space(1)))
#define LAS __attribute__((address_space(3)))
typedef unsigned short bf16;
typedef unsigned v4u __attribute__((ext_vector_type(4)));
typedef float f32x4 __attribute__((ext_vector_type(4)));
typedef short bf16x8 __attribute__((ext_vector_type(8)));
typedef GAS unsigned gu32;
typedef GAS unsigned long long gu64;
#define RLX_AGENT __ATOMIC_RELAXED, __HIP_MEMORY_SCOPE_AGENT
#define LDS_WAIT() asm volatile("s_waitcnt lgkmcnt(0)" ::: "memory")
#define VM_WAIT() asm volatile("s_waitcnt vmcnt(0)" ::: "memory")
__device__ __forceinline__ unsigned long long rt() { return __builtin_amdgcn_s_memrealtime(); }
__device__ __forceinline__ unsigned f2bf(float f) { unsigned u = __builtin_bit_cast(unsigned, f); return (u + 0x7fffu + ((u >> 16) & 1u)) >> 16; }
__device__ __forceinline__ unsigned pk2(float lo, float hi) { return f2bf(lo) | (f2bf(hi) << 16); }
#define XB_TMO      128
#define XB_XCNT(j)  (256  + 64 * (j))
#define XB_XSUB(j)  (1280 + 64 * (j))
#define XB_XGEN(j)  (2304 + 64 * (j))
#define XB_TOP      3328
#define XB_TOPGEN   3392
#define XCD_BAR_WORDS 3456
#define XB_SPIN_CAP (1u << 18)

__device__ __forceinline__ unsigned xb_ld(unsigned* p)              { return __hip_atomic_load(p, __ATOMIC_RELAXED, __HIP_MEMORY_SCOPE_AGENT); }
__device__ __forceinline__ unsigned xb_add(unsigned* p, unsigned v) { return __hip_atomic_fetch_add(p, v, __ATOMIC_RELAXED, __HIP_MEMORY_SCOPE_AGENT); }
__device__ __forceinline__ unsigned xb_xcc_id() { return (unsigned)__builtin_amdgcn_s_getreg((3 << 11) | 20) & 0xFu; }
#define XB_SPIN(cond, bar) do { unsigned _sp = 0; while (cond) { __builtin_amdgcn_s_sleep(1); \
    if ((++_sp & 255u) == 0u) { if (xb_ld(&(bar)[XB_TMO])) break; if (_sp > XB_SPIN_CAP) { atomicAdd(&(bar)[XB_TMO], 1u); break; } } } } while (0)

struct XcdBarrier {
    unsigned* bar; unsigned x;
    volatile LAS unsigned* st;
};

__device__ __forceinline__ XcdBarrier xcd_barrier_post(unsigned* bar, volatile LAS unsigned* st) {
    XcdBarrier b; b.bar = bar; b.x = xb_xcc_id(); b.st = st;
    if (threadIdx.x == 0) (void)xb_add(&bar[XB_XCNT(b.x)], 1u);
    return b;
}
__device__ __forceinline__ void xcd_barrier_complete(unsigned* bar, unsigned x, unsigned& nloc, unsigned& nx) {
    const unsigned G = gridDim.x * gridDim.y * gridDim.z;
    unsigned sum, cnt, mine, sp = 0u;
    for (;;) {
        sum = 0u; cnt = 0u; mine = 0u;
#pragma unroll
        for (unsigned j = 0; j < 16; ++j) { const unsigned c = xb_ld(&bar[XB_XCNT(j)]); sum += c; cnt += (c > 0u) ? 1u : 0u; mine = (j == x) ? c : mine; }
        if (sum == G) break;
        __builtin_amdgcn_s_sleep(1);
        if ((++sp & 255u) == 0u) { if (xb_ld(&bar[XB_TMO])) break; if (sp > XB_SPIN_CAP) { atomicAdd(&bar[XB_TMO], 1u); break; } }
    }
    nloc = mine > 0u ? mine : 1u; nx = cnt > 0u ? cnt : 1u;
}

__device__ __forceinline__ void xcd_barrier(const XcdBarrier& b) {
    asm volatile("s_waitcnt vmcnt(0)" ::: "memory");
    __syncthreads();
    if (threadIdx.x == 0) {
        unsigned* bar = b.bar;
        __builtin_amdgcn_s_waitcnt(0);
        unsigned nloc = b.st[0], nx = b.st[1];
        if (nloc == 0u) { xcd_barrier_complete(bar, b.x, nloc, nx); b.st[0] = nloc; b.st[1] = nx; }
        const unsigned old = xb_add(&bar[XB_XSUB(b.x)], 1u);
        const unsigned gen = old / nloc;
        if (old + 1u == (gen + 1u) * nloc) {
            __builtin_amdgcn_fence(__ATOMIC_RELEASE, "agent");
            asm volatile("s_waitcnt vmcnt(0)" ::: "memory");
            const unsigned og = xb_add(&bar[XB_TOP], 1u);
            const unsigned tg = og / nx;
            if (og + 1u == (tg + 1u) * nx) xb_add(&bar[XB_TOPGEN], 1u);
            else XB_SPIN(xb_ld(&bar[XB_TOPGEN]) == tg, bar);
            __builtin_amdgcn_fence(__ATOMIC_ACQUIRE, "agent");
            xb_add(&bar[XB_XGEN(b.x)], 1u);
            asm volatile("s_waitcnt vmcnt(0)" ::: "memory");
        } else {
            XB_SPIN(xb_ld(&bar[XB_XGEN(b.x)]) == gen, bar);
            __builtin_amdgcn_fence(__ATOMIC_ACQUIRE, "agent");
            asm volatile("s_waitcnt vmcnt(0)" ::: "memory");
        }
    }
    __syncthreads();
}
__device__ __forceinline__ void p0_transpose_item(const float* W, int K, int N, bf16* WT, int row_off, LAS float* scr, int item, int lane) {
    const int nblk = N / 32, kb = item / nblk, nb = item % nblk, k0 = 64 * kb, n0 = 32 * nb;
#pragma unroll 8
    for (int i = 0; i < 32; ++i) { const int kk = 2 * i + (lane >> 5); scr[kk * 33 + (lane & 31)] = W[(size_t)(k0 + kk) * N + n0 + (lane & 31)]; }
    LDS_WAIT(); asm volatile("" ::: "memory");
    const int c = lane & 7;
#pragma unroll
    for (int j = 0; j < 4; ++j) { const int n = (lane >> 3) + 8 * j; const LAS float* s = scr + (8 * c) * 33 + n;
        v4u o; o.x = pk2(s[0 * 33], s[1 * 33]); o.y = pk2(s[2 * 33], s[3 * 33]); o.z = pk2(s[4 * 33], s[5 * 33]); o.w = pk2(s[6 * 33], s[7 * 33]);
        *(GAS v4u*)(WT + (size_t)(row_off + n0 + n) * K + k0 + 8 * c) = o; }
    LDS_WAIT(); asm volatile("" ::: "memory");
}
namespace pg8 {
typedef unsigned u32x2 __attribute__((ext_vector_type(2)));
struct EpiF32 {
    static constexpr bool PERM = false, AFTER_DRAIN = false;
    float* C; int ldc;
    __device__ __forceinline__ void operator()(const f32x4 (&acc)[2][2][4][2], const Unit& u, int wr, int wc, int fr, int fq) const {
        const int row0 = u.pm * BM + wr * 64 + fr, col0 = u.pn * BM + wc * 32 + 4 * fq;
#pragma unroll
        for (int ai = 0; ai < 2; ++ai)
#pragma unroll
            for (int m = 0; m < 4; ++m) { float* rowp = C + (size_t)(row0 + ai * HALF + m * 16) * ldc + col0;
#pragma unroll
                for (int bj = 0; bj < 2; ++bj)
#pragma unroll
                    for (int n = 0; n < 2; ++n) *(f32x4*)(rowp + bj * HALF + n * 16) = acc[ai][bj][m][n]; }
    }
};
struct EpiRelu2 {
    static constexpr bool PERM = true, AFTER_DRAIN = false;
    bf16_t* O; int ldc;
    __device__ __forceinline__ void operator()(const f32x4 (&acc)[2][2][4][2], const Unit& u, int wr, int wc, int fr, int fq) const {
        const int row0 = u.pm * BM + wr * 64 + fr, col0 = u.pn * BM + wc * 32 + 8 * fq;
#pragma unroll
        for (int ai = 0; ai < 2; ++ai)
#pragma unroll
            for (int m = 0; m < 4; ++m) { bf16_t* rowp = O + (size_t)(row0 + ai * HALF + m * 16) * ldc + col0;
#pragma unroll
                for (int bj = 0; bj < 2; ++bj) { f32x4 v0 = acc[ai][bj][m][0], v1 = acc[ai][bj][m][1];
                    v0 = __builtin_elementwise_max(v0, (f32x4){0.f, 0.f, 0.f, 0.f}); v1 = __builtin_elementwise_max(v1, (f32x4){0.f, 0.f, 0.f, 0.f});
                    v0 = v0 * v0; v1 = v1 * v1;
                    u32x4 w; w.x = cvt_pk_bf16(v0[0], v0[1]); w.y = cvt_pk_bf16(v0[2], v0[3]); w.z = cvt_pk_bf16(v1[0], v1[1]); w.w = cvt_pk_bf16(v1[2], v1[3]);
                    *(u32x4*)(rowp + bj * HALF) = w; } }
    }
};
struct EpiIn {
    static constexpr bool PERM = false, AFTER_DRAIN = false;
    bf16_t* P; float* out_na; float* out_swa; float* out_diff; const float* rope_c; const float* rope_s; int layer;
    __device__ __forceinline__ void operator()(const f32x4 (&acc)[2][2][4][2], const Unit& u, int wr, int wc, int fr, int fq) const {
        const int pn = u.pn, pm = u.pm; const bool lat = pm >= 16;
        const int row0 = pm * BM + wr * 64 + fr;
#pragma unroll
        for (int bj = 0; bj < 2; ++bj) {
            const int cg = pn * BM + bj * HALF + wc * 32;
            const bool roped = lat && (pn == 12 || pn == 13 || pn == 15 || pn == 16 || pn == 17 || pn == 18 || (pn == 14 && bj == 0));
            float* kvout = nullptr; int kvld = 512;
            if (!lat) {
                const size_t bl = (size_t)(pm * 4 + layer) * 2;
                if (pn == 2 || pn == 3)        kvout = out_na + (bl + 0) * 131072 + (pn - 2) * 256 + bj * HALF + wc * 32;
                else if (pn == 4 || pn == 5)   kvout = out_na + (bl + 1) * 131072 + (pn - 4) * 256 + bj * HALF + wc * 32;
                else if (pn == 14)           { kvout = out_swa + (bl + bj) * 32768 + wc * 32; kvld = 128; }
                else if (pn == 17 || pn == 18) kvout = out_diff + (bl + 0) * 131072 + (pn - 17) * 256 + bj * HALF + wc * 32;
                else if (pn == 19 || pn == 20) kvout = out_diff + (bl + 1) * 131072 + (pn - 19) * 256 + bj * HALF + wc * 32;
            }
#pragma unroll
            for (int ai = 0; ai < 2; ++ai)
#pragma unroll
                for (int m = 0; m < 4; ++m) {
                    const int row = row0 + ai * HALF + m * 16;
                    f32x4 v0 = acc[ai][bj][m][0], v1 = acc[ai][bj][m][1];
                    if (roped) {
                        const int t = (row - 4096) & 2047; const int pos = (wc & 1) ? (t & 63) : (t >> 6);
                        const f32x4 cv = *(const f32x4*)(rope_c + pos * 16 + 4 * fq), sv = *(const f32x4*)(rope_s + pos * 16 + 4 * fq);
                        const f32x4 o0 = v0 * cv - v1 * sv, o1 = v0 * sv + v1 * cv; v0 = o0; v1 = o1;
                    }
                    u32x2 w0, w1; w0.x = cvt_pk_bf16(v0[0], v0[1]); w0.y = cvt_pk_bf16(v0[2], v0[3]); w1.x = cvt_pk_bf16(v1[0], v1[1]); w1.y = cvt_pk_bf16(v1[2], v1[3]);
                    bf16_t* pp = P + (size_t)row * 5376 + cg + 4 * fq;
                    *(u32x2*)pp = w0; *(u32x2*)(pp + 16) = w1;
                    if (kvout) { float* d = kvout + (size_t)(row - pm * BM) * kvld + 4 * fq; *(f32x4*)d = v0; *(f32x4*)(d + 16) = v1; }
                }
        }
    }
};
}

namespace mx {
typedef short s16x4 __attribute__((ext_vector_type(4)));
typedef float f32x16 __attribute__((ext_vector_type(16)));
typedef unsigned u32x2 __attribute__((ext_vector_type(2)));
typedef float f32x2_t __attribute__((ext_vector_type(2)));
typedef __bf16 bf16x2_t __attribute__((ext_vector_type(2)));
constexpr float LOG2E = 1.4426950408889634f;
constexpr float CS = 0.125f * LOG2E;
constexpr int NP = 5376;
constexpr float NEG_INF = -__builtin_huge_valf();
#define MX_DI __device__ __forceinline__
#define MX_MFMA(a, b, c) __builtin_amdgcn_mfma_f32_32x32x16_bf16((a), (b), (c), 0, 0, 0)
MX_DI unsigned cvtpk(float lo, float hi) { f32x2_t v = {lo, hi}; bf16x2_t b = __builtin_convertvector(v, bf16x2_t); return __builtin_bit_cast(unsigned, b); }
MX_DI float xhalf(float v) { return __shfl_xor(v, 32); }
MX_DI float wsum(float v) {
#pragma unroll
    for (int o = 1; o < 64; o <<= 1) v += __shfl_xor(v, o);
    return v;
}
MX_DI int crow(int reg, int h) { return (reg & 3) + 8 * (reg >> 2) + 4 * h; }
template <int S> MX_DI bf16x8 pack8(const f32x16& x) {
    v4u p; p.x = cvtpk(x[8 * S + 0], x[8 * S + 1]); p.y = cvtpk(x[8 * S + 2], x[8 * S + 3]); p.z = cvtpk(x[8 * S + 4], x[8 * S + 5]); p.w = cvtpk(x[8 * S + 6], x[8 * S + 7]);
    return __builtin_bit_cast(bf16x8, p);
}
MX_DI s16x4 vtr(const LAS unsigned char* p) { typedef short v4i16_t __attribute__((ext_vector_type(4))); return __builtin_bit_cast(s16x4, __builtin_amdgcn_ds_read_tr16_b64_v4i16((LAS v4i16_t*)p)); }

MX_DI void qk_tile(f32x16 (&s)[2], const bf16* kbase, int kp, int pos0, int hi_, const bf16x8 (&qf)[4], int r, int h) {
#pragma unroll
    for (int g = 0; g < 2; ++g) {
        int pos = pos0 + 32 * g + r; pos = pos < 0 ? 0 : (pos > hi_ ? hi_ : pos);
        const bf16* kr = kbase + (size_t)pos * kp + 8 * h;
        const bf16x8 k0 = *(const bf16x8*)(kr), k1 = *(const bf16x8*)(kr + 16), k2 = *(const bf16x8*)(kr + 32), k3 = *(const bf16x8*)(kr + 48);
        f32x16 a;
#pragma unroll
        for (int i = 0; i < 16; ++i) a[i] = 0.f;
        a = MX_MFMA(k0, qf[0], a); a = MX_MFMA(k1, qf[1], a); a = MX_MFMA(k2, qf[2], a); a = MX_MFMA(k3, qf[3], a);
        s[g] = a;
    }
}
MX_DI f32x16 qk_group(const bf16* kbase, int kp, int pos0, int hi_, const bf16x8 (&qf)[4], int r, int h) {
    int pos = pos0 + r; pos = pos < 0 ? 0 : (pos > hi_ ? hi_ : pos);
    const bf16* kr = kbase + (size_t)pos * kp + 8 * h;
    const bf16x8 k0 = *(const bf16x8*)(kr), k1 = *(const bf16x8*)(kr + 16), k2 = *(const bf16x8*)(kr + 32), k3 = *(const bf16x8*)(kr + 48);
    f32x16 a;
#pragma unroll
    for (int i = 0; i < 16; ++i) a[i] = 0.f;
    a = MX_MFMA(k0, qf[0], a); a = MX_MFMA(k1, qf[1], a); a = MX_MFMA(k2, qf[2], a); a = MX_MFMA(k3, qf[3], a);
    return a;
}
template <int DV> MX_DI void v_dma(const bf16* vbase, int vp, int pos0, int hi_, LAS unsigned char* vimg, int lane) {
    constexpr int CPR = DV / 8;
#pragma unroll
    for (int i = 0; i < DV / 8; ++i) {
        const int c = 64 * i + lane, row = c / CPR, chp = c % CPR;
        const int sw = (DV == 64) ? (((row >> 1) & 1) << 2) : ((row & 3) << 2);
        const int ch = chp ^ sw;
        int pos = pos0 + row; pos = pos < 0 ? 0 : (pos > hi_ ? hi_ : pos);
        const bf16* src = vbase + (size_t)pos * vp + ch * 8;
        __builtin_amdgcn_global_load_lds((const unsigned*)src, (LAS unsigned*)(vimg + i * 1024), 16, 0, 0);
    }
}
template <int DV> MX_DI void pv_tile(f32x16 (&o)[DV / 32], const bf16x8 (&pf)[2][2], const LAS unsigned char* vimg, int lane) {
    constexpr int RS = DV * 2;
    const int h = lane >> 5, blk = (lane >> 4) & 1, q = (lane >> 2) & 3, p = lane & 3;
    const int sq = (DV == 64) ? ((q >> 1) & 1) : q;
    const LAS unsigned char* tb = vimg + (4 * h + q) * RS + (2 * blk + (p >> 1)) * 16 + (p & 1) * 8;
#pragma unroll
    for (int g = 0; g < 2; ++g)
#pragma unroll
        for (int s = 0; s < 2; ++s) {
#pragma unroll
            for (int db = 0; db < DV / 32; ++db) {
                const LAS unsigned char* a = tb + (32 * g + 16 * s) * RS + ((db ^ sq) * 64);
                const s16x4 lo = vtr(a), hi = vtr(a + 8 * RS);
                const bf16x8 va = __builtin_shufflevector(lo, hi, 0, 1, 2, 3, 4, 5, 6, 7);
                o[db] = MX_MFMA(va, pf[g][s], o[db]);
            }
            __builtin_amdgcn_sched_barrier(0);
        }
}

template <int MODE>
MX_DI void attn64(const bf16* qrow, const bf16* Kc, const bf16* Vc, int pc, int ntc, const bf16* Kl, const bf16* Vl, int pl, int ntl, int lstart, int llen,
                  int qa, int qb, const float* rpb, bool has_sink, float sink, LAS unsigned char* vimg, bf16* outp, int lane) {
    const int r = lane & 31, h = lane >> 5;
    bf16x8 qf[4];
#pragma unroll
    for (int ds = 0; ds < 4; ++ds) qf[ds] = *(const bf16x8*)(qrow + 16 * ds + 8 * h);
    f32x16 o[2];
#pragma unroll
    for (int i = 0; i < 16; ++i) { o[0][i] = 0.f; o[1][i] = 0.f; }
    float m = NEG_INF, l = 0.f;
    const int nt = ntc + ntl;
    for (int t = 0; t < nt; ++t) {
        const bool isc = t < ntc;
        const bf16* kb = isc ? Kc : Kl; const bf16* vb = isc ? Vc : Vl; const int kp = isc ? pc : pl;
        const int pos0 = isc ? 64 * t : lstart + 64 * (t - ntc); const int hi_ = isc ? 255 : llen - 1;
        asm volatile("s_waitcnt lgkmcnt(0)" ::: "memory");
        v_dma<64>(vb, kp, pos0, hi_, vimg, lane);
        f32x16 s[2]; qk_tile(s, kb, kp, pos0, hi_, qf, r, h);
        float mxv = NEG_INF;
#pragma unroll
        for (int g = 0; g < 2; ++g)
#pragma unroll
            for (int i = 0; i < 16; ++i) {
                const int kk = 32 * g + crow(i, h);
                float tv = s[g][i] * CS;
                if (MODE == 1) { if (!isc) { const int kpos = pos0 + kk; const int d = qa - kpos; const bool ok = (kpos >= 0) && (kpos < llen) && (d <= 128) && (d >= -128); tv = ok ? tv : NEG_INF; } }
                if (MODE == 2) { if (!isc) { const int kc = kk, krow = pos0 >> 6; int cs = qa - 8; cs = cs < 0 ? 0 : (cs > 48 ? 48 : cs); const bool ok = (kc >= cs) && (kc < cs + 16);
                        const int idx = ok ? ((krow - qb + 7) * 31 + (kc - qa + 15)) : 0; const float bias = rpb[idx] * LOG2E; tv = ok ? tv + bias : NEG_INF; } }
                s[g][i] = tv; mxv = fmaxf(mxv, tv);
            }
        mxv = fmaxf(mxv, xhalf(mxv));
        const float mnew = fmaxf(m, mxv), alpha = __builtin_amdgcn_exp2f(m - mnew); m = mnew;
        float ls = 0.f;
#pragma unroll
        for (int g = 0; g < 2; ++g)
#pragma unroll
            for (int i = 0; i < 16; ++i) { const float pv_ = __builtin_amdgcn_exp2f(s[g][i] - mnew); s[g][i] = pv_; ls += pv_; }
        l = l * alpha + ls;
#pragma unroll
        for (int i = 0; i < 16; ++i) { o[0][i] *= alpha; o[1][i] *= alpha; }
        bf16x8 pf[2][2]; pf[0][0] = pack8<0>(s[0]); pf[0][1] = pack8<1>(s[0]); pf[1][0] = pack8<0>(s[1]); pf[1][1] = pack8<1>(s[1]);
        asm volatile("s_waitcnt vmcnt(0)" ::: "memory");
        pv_tile<64>(o, pf, vimg, lane);
    }
    l += xhalf(l);
    if (has_sink) l += __builtin_amdgcn_exp2f(sink * LOG2E - m);
    const float inv = 1.0f / l;
#pragma unroll
    for (int db = 0; db < 2; ++db)
#pragma unroll
        for (int g4 = 0; g4 < 4; ++g4) {
            u32x2 w; w.x = cvtpk(o[db][4 * g4 + 0] * inv, o[db][4 * g4 + 1] * inv); w.y = cvtpk(o[db][4 * g4 + 2] * inv, o[db][4 * g4 + 3] * inv);
            *(u32x2*)(outp + 32 * db + 8 * g4 + 4 * h) = w;
        }
}

MX_DI void attn_diff(const bf16* q1row, const bf16* K1c, const bf16* Vc, int pc, int ntc, const bf16* K1l, const bf16* Vl, int pl, int ntl, int llen,
                     float lam, float one_m_li, const float* dg, LAS unsigned char* vimg, bf16* outp, int lane) {
    const int r = lane & 31, h = lane >> 5;
    bf16x8 qf1[4], qf2[4];
#pragma unroll
    for (int ds = 0; ds < 4; ++ds) { qf1[ds] = *(const bf16x8*)(q1row + 16 * ds + 8 * h); qf2[ds] = *(const bf16x8*)(q1row + 64 + 16 * ds + 8 * h); }
    const int nt = ntc + ntl;
    float m1 = NEG_INF, l1 = 0.f, m2 = NEG_INF, l2 = 0.f;
    for (int t = 0; t < nt; ++t) {
        const bool isc = t < ntc;
        const bf16* kb = isc ? K1c : K1l; const int kp = isc ? pc : pl; const int pos0 = isc ? 64 * t : 64 * (t - ntc); const int hi_ = isc ? 255 : llen - 1;
#pragma unroll
        for (int br = 0; br < 2; ++br) {
            f32x16 s[2];
            if (br == 0) qk_tile(s, kb, kp, pos0, hi_, qf1, r, h); else qk_tile(s, kb + 64, kp, pos0, hi_, qf2, r, h);
            float mxv = NEG_INF;
#pragma unroll
            for (int g = 0; g < 2; ++g)
#pragma unroll
                for (int i = 0; i < 16; ++i) { s[g][i] *= CS; mxv = fmaxf(mxv, s[g][i]); }
            mxv = fmaxf(mxv, xhalf(mxv));
            float& m = br == 0 ? m1 : m2; float& l = br == 0 ? l1 : l2;
            const float mnew = fmaxf(m, mxv), alpha = __builtin_amdgcn_exp2f(m - mnew); m = mnew;
            float ls = 0.f;
#pragma unroll
            for (int g = 0; g < 2; ++g)
#pragma unroll
                for (int i = 0; i < 16; ++i) ls += __builtin_amdgcn_exp2f(s[g][i] - mnew);
            l = l * alpha + ls;
        }
    }
    l1 += xhalf(l1); l2 += xhalf(l2);
    const float il1 = 1.0f / l1, il2 = lam / l2;
    f32x16 o[4];
#pragma unroll
    for (int db = 0; db < 4; ++db)
#pragma unroll
        for (int i = 0; i < 16; ++i) o[db][i] = 0.f;
    for (int t = 0; t < nt; ++t) {
        const bool isc = t < ntc;
        const bf16* kb = isc ? K1c : K1l; const bf16* vb = isc ? Vc : Vl; const int kp = isc ? pc : pl; const int pos0 = isc ? 64 * t : 64 * (t - ntc); const int hi_ = isc ? 255 : llen - 1;
        asm volatile("s_waitcnt lgkmcnt(0)" ::: "memory");
        v_dma<128>(vb, kp, pos0, hi_, vimg, lane);
        bf16x8 pf[2][2];
#pragma unroll
        for (int g = 0; g < 2; ++g) {
            f32x16 a = qk_group(kb, kp, pos0 + 32 * g, hi_, qf1, r, h);
#pragma unroll
            for (int i = 0; i < 16; ++i) a[i] = __builtin_amdgcn_exp2f(a[i] * CS - m1) * il1;
            const f32x16 b = qk_group(kb + 64, kp, pos0 + 32 * g, hi_, qf2, r, h);
#pragma unroll
            for (int i = 0; i < 16; ++i) a[i] -= __builtin_amdgcn_exp2f(b[i] * CS - m2) * il2;
            pf[g][0] = pack8<0>(a); pf[g][1] = pack8<1>(a);
        }
        asm volatile("s_waitcnt vmcnt(0)" ::: "memory");
        pv_tile<128>(o, pf, vimg, lane);
    }
    float ss = 0.f;
#pragma unroll
    for (int db = 0; db < 4; ++db)
#pragma unroll
        for (int i = 0; i < 16; ++i) ss += o[db][i] * o[db][i];
    ss += xhalf(ss);
    const float rs = one_m_li / sqrtf(ss * (1.0f / 128.0f) + 1e-6f);
#pragma unroll
    for (int db = 0; db < 4; ++db)
#pragma unroll
        for (int g4 = 0; g4 < 4; ++g4) {
            const int d0 = 32 * db + 8 * g4 + 4 * h;
            const f32x4 gv = *(const f32x4*)(dg + d0);
            u32x2 w; w.x = cvtpk(o[db][4 * g4 + 0] * rs * gv[0], o[db][4 * g4 + 1] * rs * gv[1]); w.y = cvtpk(o[db][4 * g4 + 2] * rs * gv[2], o[db][4 * g4 + 3] * rs * gv[3]);
            *(u32x2*)(outp + d0) = w;
        }
}

MX_DI float bf2f(short b) { return __uint_as_float(((unsigned)(unsigned short)b) << 16); }
MX_DI void conv_unit(const bf16* P, bf16* MIX, const float* cw, int r0, int seg0, int seg1, int lane) {
    const int c0 = 8 * lane;
    float w0[8], w1[8], w2[8];
#pragma unroll
    for (int e = 0; e < 8; ++e) { w0[e] = cw[c0 + e]; w1[e] = cw[512 + c0 + e]; w2[e] = cw[1024 + c0 + e]; }
    float zp[8], zc[8], zn[8];
    {
        const int rp = r0 - 1; const bool okp = rp >= seg0; const int rpc = okp ? rp : r0;
        const bf16x8 u = *(const bf16x8*)(P + (size_t)rpc * NP + 1536 + c0), gc = *(const bf16x8*)(P + (size_t)rpc * NP + 2560 + c0);
#pragma unroll
        for (int e = 0; e < 8; ++e) zp[e] = okp ? bf2f(u[e]) * bf2f(gc[e]) : 0.f;
        const bf16x8 u1 = *(const bf16x8*)(P + (size_t)r0 * NP + 1536 + c0), gc1 = *(const bf16x8*)(P + (size_t)r0 * NP + 2560 + c0);
#pragma unroll
        for (int e = 0; e < 8; ++e) zc[e] = bf2f(u1[e]) * bf2f(gc1[e]);
    }
    for (int i = 0; i < 16; ++i) {
        const int row = r0 + i, rn = row + 1; const bool okn = rn < seg1; const int rnc = okn ? rn : row;
        const bf16x8 u = *(const bf16x8*)(P + (size_t)rnc * NP + 1536 + c0), gc = *(const bf16x8*)(P + (size_t)rnc * NP + 2560 + c0);
        const bf16x8 gb = *(const bf16x8*)(P + (size_t)row * NP + 2048 + c0);
#pragma unroll
        for (int e = 0; e < 8; ++e) zn[e] = okn ? bf2f(u[e]) * bf2f(gc[e]) : 0.f;
        float y[8];
#pragma unroll
        for (int e = 0; e < 8; ++e) y[e] = bf2f(gb[e]) * (w0[e] * zp[e] + w1[e] * zc[e] + w2[e] * zn[e]);
        v4u w; w.x = cvtpk(y[0], y[1]); w.y = cvtpk(y[2], y[3]); w.z = cvtpk(y[4], y[5]); w.w = cvtpk(y[6], y[7]);
        *(v4u*)(MIX + (size_t)row * 2048 + 512 + c0) = w;
#pragma unroll
        for (int e = 0; e < 8; ++e) { zp[e] = zc[e]; zc[e] = zn[e]; }
    }
}

struct MixArgs { const bf16* P; bf16* MIX; const bf16* cna; const bf16* cswa; const bf16* cdiff; const float* conv_w; const float* rpb; const float* sink; const float* dlam; const float* dg; float lam_init; int layer; };
constexpr int U_LDIFF = 512, U_LNA = 1024, U_LSWA = 1024, U_CDIFF = 512, U_CMHA = 1024, U_CGQA = 1024, U_CONV = 512;
constexpr int NUNITS = U_LDIFF + U_LNA + U_LSWA + U_CDIFF + U_CMHA + U_CGQA + U_CONV;
MX_DI void mix_unit(const MixArgs& A, int u, LAS unsigned char* vimg, int lane) {
    const int r = lane & 31, l = A.layer;
    if (u < U_LDIFF + 0) {
        const int rb = u >> 2, hh = u & 3, b = rb >> 6, q0 = (rb & 63) * 32;
        const size_t lrow0 = 4096 + (size_t)b * 2048;
        float pr = 0.f; { const float a0 = A.dlam[lane] * A.dlam[64 + lane], a1 = A.dlam[128 + lane] * A.dlam[192 + lane]; const float s0 = wsum(a0), s1 = wsum(a1); pr = __expf(s0) - __expf(s1) + A.lam_init; }
        const bf16* cd = A.cdiff + (size_t)((b * 4 + l) * 2) * 256 * 512;
        attn_diff(A.P + (lrow0 + q0 + r) * NP + 3840 + 128 * hh, cd + 128 * hh, cd + 256 * 512 + 128 * hh, 512, 4,
                  A.P + lrow0 * NP + 4352 + 128 * hh, A.P + lrow0 * NP + 4864 + 128 * hh, NP, 32, 2048,
                  pr, 1.0f - A.lam_init, A.dg, vimg, A.MIX + (lrow0 + q0 + r) * 2048 + 1536 + 128 * hh, lane);
        return;
    }
    u -= U_LDIFF;
    if (u < U_LNA) {
        const int rb = u >> 3, hh = u & 7, b = rb >> 6, t0 = (rb & 63) * 32;
        const size_t lrow0 = 4096 + (size_t)b * 2048;
        const int qr = t0 >> 6, qc = (t0 & 63) + r; int kr0 = qr - 4; kr0 = kr0 < 0 ? 0 : (kr0 > 24 ? 24 : kr0);
        const bf16* cn = A.cna + (size_t)((b * 4 + l) * 2) * 256 * 512;
        attn64<2>(A.P + (lrow0 + t0 + r) * NP + 0 + 64 * hh, cn + 64 * hh, cn + 256 * 512 + 64 * hh, 512, 4,
                  A.P + lrow0 * NP + 512 + 64 * hh, A.P + lrow0 * NP + 1024 + 64 * hh, NP, 8, kr0 * 64, 2048,
                  qc, qr, A.rpb + hh * 465, false, 0.f, vimg, A.MIX + (lrow0 + t0 + r) * 2048 + 0 + 64 * hh, lane);
        return;
    }
    u -= U_LNA;
    if (u < U_LSWA) {
        const int rb = u >> 3, hq = u & 7, kvh = hq >> 2, b = rb >> 6, q0 = (rb & 63) * 32;
        const size_t lrow0 = 4096 + (size_t)b * 2048;
        const bf16* cs = A.cswa + (size_t)((b * 4 + l) * 2) * 256 * 128;
        attn64<1>(A.P + (lrow0 + q0 + r) * NP + 3072 + 64 * hq, cs + 64 * kvh, cs + 256 * 128 + 64 * kvh, 128, 4,
                  A.P + lrow0 * NP + 3584 + 64 * kvh, A.P + lrow0 * NP + 3712 + 64 * kvh, NP, 5, q0 - 128, 2048,
                  q0 + r, 0, nullptr, true, A.sink[hq], vimg, A.MIX + (lrow0 + q0 + r) * 2048 + 1024 + 64 * hq, lane);
        return;
    }
    u -= U_LSWA;
    if (u < U_CDIFF) {
        const int rb = u >> 2, hh = u & 3, b = rb >> 3, q0 = (rb & 7) * 32;
        const size_t crow0 = (size_t)b * 256;
        float pr = 0.f; { const float a0 = A.dlam[lane] * A.dlam[64 + lane], a1 = A.dlam[128 + lane] * A.dlam[192 + lane]; const float s0 = wsum(a0), s1 = wsum(a1); pr = __expf(s0) - __expf(s1) + A.lam_init; }
        attn_diff(A.P + (crow0 + q0 + r) * NP + 3840 + 128 * hh, nullptr, nullptr, 0, 0,
                  A.P + crow0 * NP + 4352 + 128 * hh, A.P + crow0 * NP + 4864 + 128 * hh, NP, 4, 256,
                  pr, 1.0f - A.lam_init, A.dg, vimg, A.MIX + (crow0 + q0 + r) * 2048 + 1536 + 128 * hh, lane);
        return;
    }
    u -= U_CDIFF;
    if (u < U_CMHA) {
        const int rb = u >> 3, hh = u & 7, b = rb >> 3, q0 = (rb & 7) * 32;
        const size_t crow0 = (size_t)b * 256;
        attn64<0>(A.P + (crow0 + q0 + r) * NP + 0 + 64 * hh, nullptr, nullptr, 0, 0,
                  A.P + crow0 * NP + 512 + 64 * hh, A.P + crow0 * NP + 1024 + 64 * hh, NP, 4, 0, 256,
                  0, 0, nullptr, false, 0.f, vimg, A.MIX + (crow0 + q0 + r) * 2048 + 0 + 64 * hh, lane);
        return;
    }
    u -= U_CMHA;
    if (u < U_CGQA) {
        const int rb = u >> 3, hq = u & 7, kvh = hq >> 2, b = rb >> 3, q0 = (rb & 7) * 32;
        const size_t crow0 = (size_t)b * 256;
        attn64<0>(A.P + (crow0 + q0 + r) * NP + 3072 + 64 * hq, nullptr, nullptr, 0, 0,
                  A.P + crow0 * NP + 3584 + 64 * kvh, A.P + crow0 * NP + 3712 + 64 * kvh, NP, 4, 0, 256,
                  0, 0, nullptr, true, A.sink[hq], vimg, A.MIX + (crow0 + q0 + r) * 2048 + 1024 + 64 * hq, lane);
        return;
    }
    u -= U_CGQA;
    {
        const int r0 = u * 16; int seg0, seg1;
        if (r0 < 4096) { seg0 = r0 & ~255; seg1 = seg0 + 256; } else { seg0 = 4096 + ((r0 - 4096) & ~2047); seg1 = seg0 + 2048; }
        conv_unit(A.P, A.MIX, A.conv_w, r0, seg0, seg1, lane);
    }
}
}

constexpr int NWAVES = 8;
constexpr int D = 2048, NTOK = 8192, NCTX = 4096, NIN = 5376, FF = 8192, DEPTH = 4;
constexpr size_t MiB = 1u << 20;
constexpr size_t WS_CTL = 0, CTL_ZERO_BYTES = 1 * MiB;
constexpr size_t WS_ROPE = 1 * MiB;
constexpr size_t WS_MOD = 2 * MiB;
constexpr size_t WS_MODP = 4 * MiB;
constexpr size_t WS_CNA = 10 * MiB, WS_CSWA = 14 * MiB, WS_CDIFF = 15 * MiB;
constexpr size_t WS_WIN = 32 * MiB, WS_WOUT = 116 * MiB, WS_W1 = 148 * MiB, WS_W2 = 276 * MiB;
constexpr size_t WS_H = 404 * MiB, WS_P = 436 * MiB, WS_MIX = 520 * MiB, WS_Y = 552 * MiB, WS_F = 616 * MiB, WS_END = 744 * MiB;
constexpr int CW_BAR = 4096;
constexpr int CW_Q = 16384;
static_assert((CW_Q + 64 * 8) * 4 <= (int)CTL_ZERO_BYTES && CW_BAR + XCD_BAR_WORDS <= CW_Q, "ctl map");
constexpr size_t OUT_YS = 8388608, OUT_NA = 16777216, OUT_SWA = 33554432, OUT_DIFF = 37748736, OUT_TOTAL = 54525952;
constexpr int RING_BYTES = 131072, MISC_OFF = RING_BYTES + 320, LDS_BYTES = 147456;
constexpr float RMS_EPS = 1e-6f;

struct Args { const float* in[19]; float* out; unsigned char* ws; float lam_init[4]; };
typedef const __attribute__((address_space(4))) Args* ArgsP;
__device__ __forceinline__ ArgsP get_args() { ArgsP p = (ArgsP)__builtin_amdgcn_kernarg_segment_ptr(); asm volatile("" : "+s"(p)); return p; }

__device__ __forceinline__ float wave_sum(float v) {
#pragma unroll
    for (int o = 1; o < 64; o <<= 1) v += __shfl_xor(v, o);
    return v;
}
__device__ __forceinline__ const float* mod_row(const float* MOD, int l, int v, int i) { return MOD + ((size_t)(l * 3 + v) * 6 + i) * D; }
__device__ __forceinline__ int row_vec(int row) { return row < NCTX ? 0 : 1 + ((row - NCTX) >> 11); }

__device__ __forceinline__ void norm_mod_store(const f32x4 (&x)[8], const float* g, const float* ms, const float* mb, bf16* orow, int lane) {
    float ss = 0.f;
#pragma unroll
    for (int j = 0; j < 8; ++j) ss += (x[j].x * x[j].x + x[j].y * x[j].y) + (x[j].z * x[j].z + x[j].w * x[j].w);
    const float rs = 1.0f / sqrtf(wave_sum(ss) * (1.0f / D) + RMS_EPS);
#pragma unroll
    for (int j = 0; j < 8; ++j) { const int c = lane + 64 * j;
        const f32x4 gv = ((const f32x4*)g)[c], sv = ((const f32x4*)ms)[c], bv = ((const f32x4*)mb)[c];
        const f32x4 y = (x[j] * rs) * gv * (sv + 1.0f) + bv;
        ((unsigned long long*)orow)[c] = (unsigned long long)pk2(y.x, y.y) | ((unsigned long long)pk2(y.z, y.w) << 32); }
}
__device__ __forceinline__ void resid_norm(f32x4 (&x)[8], const f32x4 (&y)[8], const float* g, const float* mg, int lane) {
    float ss = 0.f;
#pragma unroll
    for (int j = 0; j < 8; ++j) ss += (y[j].x * y[j].x + y[j].y * y[j].y) + (y[j].z * y[j].z + y[j].w * y[j].w);
    const float rs = 1.0f / sqrtf(wave_sum(ss) * (1.0f / D) + RMS_EPS);
#pragma unroll
    for (int j = 0; j < 8; ++j) { const int c = lane + 64 * j; const f32x4 gv = ((const f32x4*)g)[c], mv = ((const f32x4*)mg)[c]; x[j] = x[j] + mv * ((y[j] * rs) * gv); }
}

#define WSP(T, off) ((T*)(ap->ws + (off)))
__device__ __forceinline__ int fresh_lane() { int t = threadIdx.x; asm volatile("" : "+v"(t)); return t & 63; }
__global__ void __launch_bounds__(NWAVES * 64, 2) fwd(Args args_unused) {
    extern __shared__ __attribute__((aligned(16))) unsigned char lds_raw[];
    LAS unsigned char* lds = (LAS unsigned char*)lds_raw;
    const int tid = threadIdx.x, wave = __builtin_amdgcn_readfirstlane(tid >> 6);
    const int G = gridDim.x, gw = blockIdx.x * NWAVES + wave, NGW = G * NWAVES;
    volatile LAS unsigned* MISC = (volatile LAS unsigned*)(lds + MISC_OFF);
    for (int u = tid; u < (LDS_BYTES - RING_BYTES) / 4; u += NWAVES * 64) ((LAS unsigned*)(lds + RING_BYTES))[u] = 0u;
    __syncthreads();
    XcdBarrier bar;
    { ArgsP ap = get_args(); bar = xcd_barrier_post(WSP(unsigned, WS_CTL) + CW_BAR, MISC + 8); }
    LAS unsigned char* wlds = lds + wave * 16384;

    {
        for (int it = gw; it < DEPTH * 8 * 48; it += NGW) {
            ArgsP ap = get_args(); const int lane = fresh_lane();
            const int cb = it % 48, ks = (it / 48) % 8, l = it / (48 * 8);
            LAS float* sil = (LAS float*)wlds;
            const float* cc = ap->in[5]; const float* cx = ap->in[6];
#pragma unroll
            for (int j = 0; j < 4; ++j) { const int k = 256 * ks + lane + 64 * j;
                const float c0 = cx[k], c1 = cc[k], c2 = cc[D + k];
                sil[lane + 64 * j] = c0 / (1.0f + __expf(-c0)); sil[256 + lane + 64 * j] = c1 / (1.0f + __expf(-c1)); sil[512 + lane + 64 * j] = c2 / (1.0f + __expf(-c2)); }
            LDS_WAIT(); asm volatile("" ::: "memory");
            const float* W = ap->in[7] + ((size_t)l * D + 256 * ks) * 12288 + 256 * cb + 4 * lane;
            f32x4 a0 = {0.f, 0.f, 0.f, 0.f}, a1 = a0, a2 = a0;
#pragma unroll 8
            for (int k = 0; k < 256; ++k) { const f32x4 w = *(const f32x4*)(W + (size_t)k * 12288); a0 += w * sil[k]; a1 += w * sil[256 + k]; a2 += w * sil[512 + k]; }
            float* dst = WSP(float, WS_MODP) + ((size_t)(ks * 4 + l) * 3) * 12288 + 256 * cb + 4 * lane;
            *(f32x4*)dst = a0; *(f32x4*)(dst + 12288) = a1; *(f32x4*)(dst + 2 * 12288) = a2;
            LDS_WAIT(); asm volatile("" ::: "memory");
        }
        {
            LAS float* scr = (LAS float*)wlds;
            constexpr int I_IN = (D / 64) * (NIN / 32), I_OUT = (D / 64) * (D / 32), I_1 = (D / 64) * (FF / 32), I_2 = (FF / 64) * (D / 32), I_L = I_IN + I_OUT + I_1 + I_2;
            for (int it = gw; it < DEPTH * I_L; it += NGW) {
                ArgsP ap = get_args(); const int lane = fresh_lane();
                const int l = it / I_L; int r = it % I_L;
                if (r < I_IN) { p0_transpose_item(ap->in[10] + (size_t)l * D * NIN, D, NIN, WSP(bf16, WS_WIN) + (size_t)l * NIN * D, 0, scr, r, lane); continue; } r -= I_IN;
                if (r < I_OUT) { p0_transpose_item(ap->in[16] + (size_t)l * D * D, D, D, WSP(bf16, WS_WOUT) + (size_t)l * D * D, 0, scr, r, lane); continue; } r -= I_OUT;
                if (r < I_1) { p0_transpose_item(ap->in[17] + (size_t)l * D * FF, D, FF, WSP(bf16, WS_W1) + (size_t)l * FF * D, 0, scr, r, lane); continue; } r -= I_1;
                p0_transpose_item(ap->in[18] + (size_t)l * FF * D, FF, D, WSP(bf16, WS_W2) + (size_t)l * D * FF, 0, scr, r, lane);
            }
        }
        {
            ArgsP ap = get_args();
            const size_t gt = (size_t)blockIdx.x * (NWAVES * 64) + tid, NT = (size_t)G * NWAVES * 64;
            for (int which = 0; which < 3; ++which) {
                const float* src = ap->in[2 + which]; bf16* dst = which == 0 ? WSP(bf16, WS_CNA) : (which == 1 ? WSP(bf16, WS_CSWA) : WSP(bf16, WS_CDIFF));
                const size_t n8 = (which == 1 ? (size_t)2 * 4 * 2 * 256 * 128 : (size_t)2 * 4 * 2 * 256 * 512) / 8;
                for (size_t i = gt; i < n8; i += NT) { const f32x4 a = ((const f32x4*)src)[2 * i], b = ((const f32x4*)src)[2 * i + 1];
                    v4u o; o.x = pk2(a.x, a.y); o.y = pk2(a.z, a.w); o.z = pk2(b.x, b.y); o.w = pk2(b.z, b.w); ((v4u*)dst)[i] = o; }
            }
        }
        if (blockIdx.x == 0) { ArgsP ap = get_args(); float* rope_c = WSP(float, WS_ROPE);
            for (int e = tid; e < 1024; e += NWAVES * 64) { const int pos = e >> 4, j = e & 15;
                const double inv = exp(-(double)j * (9.210340371976184 / 16.0)); const double ang = (double)pos * inv;
                rope_c[e] = (float)cos(ang); rope_c[1024 + e] = (float)sin(ang); } }
    }
    xcd_barrier(bar);
    {
        ArgsP ap = get_args();
        const float* MODP = WSP(float, WS_MODP); float* MOD = WSP(float, WS_MOD); const float* ab = ap->in[8];
        const size_t gt = (size_t)blockIdx.x * (NWAVES * 64) + tid, NT = (size_t)G * NWAVES * 64;
        for (size_t i = gt; i < (size_t)DEPTH * 3 * 12288; i += NT) { const int n = (int)(i % 12288); const int lv = (int)(i / 12288); const int l = lv / 3;
            float s = ab[(size_t)l * 12288 + n];
#pragma unroll
            for (int ks = 0; ks < 8; ++ks) s += MODP[(size_t)ks * (4 * 3 * 12288) + i];
            MOD[i] = s; }
    }
    xcd_barrier(bar);
    {
        ArgsP ap = get_args(); const int lane = fresh_lane();
        const float* xp = ap->in[0]; const float* xs = ap->in[1]; const float* g0 = ap->in[9]; const float* MOD = WSP(float, WS_MOD); bf16* Hb = WSP(bf16, WS_H);
        for (int row = gw; row < NTOK; row += NGW) {
            const float* xr = row < NCTX ? xp + (size_t)row * D : xs + (size_t)(row - NCTX) * D;
            f32x4 x[8];
#pragma unroll
            for (int j = 0; j < 8; ++j) x[j] = ((const f32x4*)xr)[lane + 64 * j];
            const int v = row_vec(row);
            norm_mod_store(x, g0, mod_row(MOD, 0, v, 1), mod_row(MOD, 0, v, 0), Hb + (size_t)row * D, lane);
        }
    }
    xcd_barrier(bar);

    for (int l = 0; l < DEPTH; ++l) {
        {
            ArgsP ap = get_args();
            pg8::Gemm g{WSP(bf16, WS_H), WSP(bf16, WS_WIN) + (size_t)l * NIN * D, NTOK, NIN, D}; pg8::StaticOrder S; S.init(NTOK, NIN, G, (int)blockIdx.x);
            float* out = ap->out; float* rope_c = WSP(float, WS_ROPE);
            pg8::EpiIn E{WSP(bf16, WS_P), out + OUT_NA, out + OUT_SWA, out + OUT_DIFF, rope_c, rope_c + 1024, l};
            pg8::gemm_phase<pg8::EpiIn, pg8::StaticOrder, true, true>(lds, g, S, E);
        }
        xcd_barrier(bar);
        {
            ArgsP ap = get_args(); const int lane = fresh_lane();
            mx::MixArgs A{WSP(bf16, WS_P), WSP(bf16, WS_MIX), WSP(bf16, WS_CNA), WSP(bf16, WS_CSWA), WSP(bf16, WS_CDIFF), ap->in[11] + (size_t)l * 3 * 512, ap->in[12] + (size_t)l * 8 * 465, ap->in[13] + l * 8, ap->in[14] + l * 256, ap->in[15] + l * 128, ap->lam_init[l], l};
            unsigned* qh = WSP(unsigned, WS_CTL) + CW_Q + 64 * l;
            for (;;) {
                unsigned u = 0; if (lane == 0) u = __hip_atomic_fetch_add(qh, 1u, __ATOMIC_RELAXED, __HIP_MEMORY_SCOPE_AGENT);
                u = (unsigned)__builtin_amdgcn_readfirstlane((int)u);
                if (u >= (unsigned)mx::NUNITS) break;
                mx::mix_unit(A, (int)u, wlds, lane);
            }
        }
        xcd_barrier(bar);
        {
            ArgsP ap = get_args();
            pg8::Gemm g{WSP(bf16, WS_MIX), WSP(bf16, WS_WOUT) + (size_t)l * D * D, NTOK, D, D}; pg8::StaticOrder S; S.init(NTOK, D, G, (int)blockIdx.x);
            pg8::EpiF32 E{WSP(float, WS_Y), D};
            pg8::gemm_phase<pg8::EpiF32, pg8::StaticOrder, true, true>(lds, g, S, E);
        }
        xcd_barrier(bar);
        {
            ArgsP ap = get_args(); const int lane = fresh_lane();
            float* out = ap->out; const float* xp = (l == 0) ? ap->in[0] : out; const float* xs = (l == 0) ? ap->in[1] : out + (size_t)NCTX * D;
            const float* ng = ap->in[9] + (size_t)l * 4 * D; const float* MOD = WSP(float, WS_MOD); bf16* Hb = WSP(bf16, WS_H); const float* Yb = WSP(float, WS_Y);
            for (int row = gw; row < NTOK; row += NGW) {
                const float* xr = row < NCTX ? xp + (size_t)row * D : xs + (size_t)(row - NCTX) * D;
                f32x4 x[8], y[8];
#pragma unroll
                for (int j = 0; j < 8; ++j) { x[j] = ((const f32x4*)xr)[lane + 64 * j]; y[j] = ((const f32x4*)(Yb + (size_t)row * D))[lane + 64 * j]; }
                const int v = row_vec(row);
                resid_norm(x, y, ng + 1 * D, mod_row(MOD, l, v, 2), lane);
#pragma unroll
                for (int j = 0; j < 8; ++j) ((f32x4*)(out + (size_t)row * D))[lane + 64 * j] = x[j];
                norm_mod_store(x, ng + 2 * D, mod_row(MOD, l, v, 4), mod_row(MOD, l, v, 3), Hb + (size_t)row * D, lane);
            }
        }
        xcd_barrier(bar);
        {
            ArgsP ap = get_args();
            pg8::Gemm g{WSP(bf16, WS_H), WSP(bf16, WS_W1) + (size_t)l * FF * D, NTOK, FF, D}; pg8::StaticOrder S; S.init(NTOK, FF, G, (int)blockIdx.x);
            pg8::EpiRelu2 E{WSP(bf16, WS_F), FF};
            pg8::gemm_phase<pg8::EpiRelu2, pg8::StaticOrder, true, true>(lds, g, S, E);
        }
        xcd_barrier(bar);
        {
            ArgsP ap = get_args();
            pg8::Gemm g{WSP(bf16, WS_F), WSP(bf16, WS_W2) + (size_t)l * D * FF, NTOK, D, FF}; pg8::StaticOrder S; S.init(NTOK, D, G, (int)blockIdx.x);
            pg8::EpiF32 E{WSP(float, WS_Y), D};
            pg8::gemm_phase<pg8::EpiF32, pg8::StaticOrder, true, true>(lds, g, S, E);
        }
        xcd_barrier(bar);
        {
            ArgsP ap = get_args(); const int lane = fresh_lane();
            float* out = ap->out; const float* ng = ap->in[9] + (size_t)l * 4 * D; const float* MOD = WSP(float, WS_MOD); bf16* Hb = WSP(bf16, WS_H); const float* Yb = WSP(float, WS_Y);
            for (int row = gw; row < NTOK; row += NGW) {
                f32x4 x[8], y[8];
#pragma unroll
                for (int j = 0; j < 8; ++j) { x[j] = ((const f32x4*)(out + (size_t)row * D))[lane + 64 * j]; y[j] = ((const f32x4*)(Yb + (size_t)row * D))[lane + 64 * j]; }
                const int v = row_vec(row);
                resid_norm(x, y, ng + 3 * D, mod_row(MOD, l, v, 5), lane);
#pragma unroll
                for (int j = 0; j < 8; ++j) ((f32x4*)(out + (size_t)row * D))[lane + 64 * j] = x[j];
                if (l + 1 < DEPTH) norm_mod_store(x, ng + 4 * D, mod_row(MOD, l + 1, v, 1), mod_row(MOD, l + 1, v, 0), Hb + (size_t)row * D, lane);
            }
        }
        if (l + 1 < DEPTH) xcd_barrier(bar);
    }
}

extern "C" void kernel_launch(void* const* d_in, const int* in_sizes, int n_in, void* d_out, int out_size, void* d_ws, size_t ws_size, hipStream_t stream) {
    static int grid = 0;
    if (grid == 0) {
        if (n_in != 19 || (size_t)out_size != OUT_TOTAL || ws_size < WS_END) { fprintf(stderr, "kernel_launch: unexpected shapes: n_in %d out %d ws %zu\n", n_in, out_size, ws_size); grid = -1; return; }
        int dev = 0, cus = 0, per_cu = 0;
        if (hipGetDevice(&dev) != hipSuccess || hipDeviceGetAttribute(&cus, hipDeviceAttributeMultiprocessorCount, dev) != hipSuccess) { grid = -1; return; }
        if (hipFuncSetAttribute((const void*)fwd, hipFuncAttributeMaxDynamicSharedMemorySize, LDS_BYTES) != hipSuccess) { fprintf(stderr, "kernel_launch: hipFuncSetAttribute failed\n"); grid = -1; return; }
        if (hipOccupancyMaxActiveBlocksPerMultiprocessor(&per_cu, (const void*)fwd, NWAVES * 64, LDS_BYTES) != hipSuccess || per_cu < 1) { fprintf(stderr, "kernel_launch: occupancy query says %d blocks per CU\n", per_cu); }
        (void)hipGetLastError();
        grid = cus;
    }
    if (grid < 0) return;
    if (hipMemsetAsync((char*)d_ws + WS_CTL, 0, CTL_ZERO_BYTES, stream) != hipSuccess) { fprintf(stderr, "kernel_launch: memset failed\n"); return; }
    Args a{};
    for (int i = 0; i < 19; ++i) a.in[i] = (const float*)d_in[i];
    a.out = (float*)d_out; a.ws = (unsigned char*)d_ws;
    for (int l = 0; l < 4; ++l) a.lam_init[l] = (float)(0.8 - 0.6 * exp(-0.3 * (double)l));
    hipLaunchKernelGGL(fwd, dim3(grid), dim3(NWAVES * 64), LDS_BYTES, stream, a);
    const hipError_t le = hipPeekAtLastError();
    if (le != hipSuccess) fprintf(stderr, "kernel_launch: launch failed: %s\n", hipGetErrorName(le));
}
```

```cpp
#include <hip/hip_runtime.h>
#include <cstdio>
#include <cstdint>
#include <cmath>
namespace pg8 {
#define PG8_LAS __attribute__((address_space(3)))
typedef unsigned short bf16_t;
typedef short bf16x8 __attribute__((ext_vector_type(8)));
typedef float f32x4 __attribute__((ext_vector_type(4)));
typedef unsigned u32x4 __attribute__((ext_vector_type(4)));
constexpr int BM = 256, BK = 64, HALF = 128, HTB = HALF * BK * 2  , STAGE_BYTES = 8 * HTB, NXCD = 8, WGM = 8;

__host__ __device__ __forceinline__ int lds_byte(int r, int c) { const int st = (r >> 4) * 2 + (c >> 5), rr = r & 15, cc = c & 31, ob = rr * 64 + cc * 2; return st * 1024 + (ob ^ (((ob >> 9) & 1) << 5)); }
__host__ __device__ __forceinline__ void stage_rc(int b, int& R, int& C) { const int st = b / 1024, sb = b % 1024, swz = sb ^ (((sb >> 9) & 1) << 5); R = (st >> 1) * 16 + swz / 64; C = (st & 1) * 32 + (swz % 64) / 2; }
__host__ __device__ __forceinline__ int perm32(int rho) { const int n = rho >> 4, i = rho & 15; return 8 * (i >> 2) + 4 * n + (i & 3); }

struct Unit { int pm, pn; };
struct Gemm { const bf16_t* A; const bf16_t* Bt; int M, N, K; };

struct StaticOrder {
    int nM, nN, nwg, G, c;
    __host__ __device__ void init(int M, int N, int G_, int c_) { nM = M / BM; nN = N / BM; nwg = nM * nN; G = G_; c = c_; }
    __host__ __device__ bool next(int i, Unit& u) const {
        const long L = (long)i * G + c; if (L >= nwg) return false;
        int wgid = (int)L; { const int q = nwg / NXCD, r = nwg % NXCD, xcd = wgid % NXCD, off = wgid / NXCD; wgid = (xcd < r ? xcd * (q + 1) : r * (q + 1) + (xcd - r) * q) + off; }
        const int nig = WGM * nN, gid = wgid / nig, fm = gid * WGM, gsz = (nM - fm) < WGM ? (nM - fm) : WGM;
        u.pm = fm + ((wgid % nig) % gsz); u.pn = (wgid % nig) / gsz; return true;
    }
    __device__ __forceinline__ void a_ready(const Unit&) const {}
    __device__ __forceinline__ void done(const Unit&) const {}
};

__device__ __forceinline__ unsigned cvt_pk_bf16(float lo, float hi) { unsigned r; asm volatile("v_cvt_pk_bf16_f32 %0, %1, %2" : "=v"(r) : "v"(lo), "v"(hi)); return r; }
typedef float f32x2 __attribute__((ext_vector_type(2)));
template <class Epi, class Sched, bool ALIGN_EPI = false, bool SP2 = false>
__device__ __forceinline__ void gemm_phase(PG8_LAS unsigned char* lds, const Gemm g, const Sched& S, const Epi& E) {
    int tid_l = threadIdx.x; asm volatile("" : "+v"(tid_l));
    const int tid = tid_l, wid = __builtin_amdgcn_readfirstlane(tid >> 6), lane = tid & 63, wr = wid >> 2, wc = wid & 3, fr = lane & 15, fq = lane >> 4;
    const int K = g.K, nt = K / BK;
    unsigned voffA[2], voffB[2];
#pragma unroll
    for (int i = 0; i < 2; ++i) { int R, C; stage_rc(tid * 16 + i * 8192, R, C); const int Rb = Epi::PERM ? ((R & ~31) + perm32(R & 31)) : R;
        voffA[i] = (unsigned)(R * K + C) * 2u; voffB[i] = (unsigned)(Rb * K + C) * 2u; }
    const size_t kstep = (size_t)(BK * 2);
    const size_t hstep = (size_t)HALF * K * 2;
    const size_t tstep = 2 * hstep;
    const unsigned ldsw = (unsigned)wid * 1024u;
    const int aoff = lds_byte(wr * 64 + fr, fq * 8), boff = lds_byte(wc * 32 + fr, fq * 8);
#define PG8_SA(b, h) (((b) * 2 + (h)) * HTB)
#define PG8_SB(b, h) ((4 + (b) * 2 + (h)) * HTB)
#define PG8_STAGE(bufoff, gbase, voff) do { _Pragma("unroll") for (int _i = 0; _i < 2; ++_i) \
        __builtin_amdgcn_global_load_lds((const unsigned*)((const char*)(gbase) + (voff)[_i]), (PG8_LAS unsigned*)(lds + (bufoff) + ldsw + _i * 8192), 16, 0, 0); } while (0)
#define PG8_LDA(dst, b, h) do { _Pragma("unroll") for (int m = 0; m < 4; ++m) _Pragma("unroll") for (int k = 0; k < 2; ++k) dst[m][k] = *(const PG8_LAS bf16x8*)(lds + PG8_SA(b, h) + aoff + m * 2048 + k * 1024); } while (0)
#define PG8_LDB(dst, b, h) do { _Pragma("unroll") for (int n = 0; n < 2; ++n) _Pragma("unroll") for (int k = 0; k < 2; ++k) dst[n][k] = *(const PG8_LAS bf16x8*)(lds + PG8_SB(b, h) + boff + n * 2048 + k * 1024); } while (0)
#define PG8_MMA(ai, bj, At, Bt) do { __builtin_amdgcn_s_setprio(1); _Pragma("unroll") for (int m = 0; m < 4; ++m) _Pragma("unroll") for (int n = 0; n < 2; ++n) _Pragma("unroll") for (int k = 0; k < 2; ++k) \
        acc[ai][bj][m][n] = __builtin_amdgcn_mfma_f32_16x16x32_bf16(Bt[n][k], At[m][k], acc[ai][bj][m][n], 0, 0, 0); __builtin_amdgcn_s_setprio(0); } while (0)
#define PG8_WAIT_V(n) asm volatile("s_waitcnt vmcnt(" #n ")" ::: "memory")
#define PG8_WAIT_L(n) asm volatile("s_waitcnt lgkmcnt(" #n ")" ::: "memory")
#define PG8_BAR __builtin_amdgcn_s_barrier()
#define PG8_SCHED __builtin_amdgcn_sched_barrier(0)
    Unit cur, nxt; int ui = 0;
    if (!S.next(0, cur)) return;
    f32x4 acc[2][2][4][2];
#pragma unroll
    for (int a = 0; a < 2; ++a)
#pragma unroll
        for (int b = 0; b < 2; ++b)
#pragma unroll
            for (int m = 0; m < 4; ++m)
#pragma unroll
                for (int n = 0; n < 2; ++n) acc[a][b][m][n] = (f32x4){0.f, 0.f, 0.f, 0.f};
    bf16x8 At[4][2], B0[2][2], B1[2][2];
    const char* cA = (const char*)g.A + (size_t)cur.pm * tstep; const char* cB = (const char*)g.Bt + (size_t)cur.pn * tstep;
    S.a_ready(cur);
    if constexpr (SP2) {
        PG8_STAGE(PG8_SB(0, 0), cB, voffB); PG8_STAGE(PG8_SB(0, 1), cB + hstep, voffB); PG8_STAGE(PG8_SA(0, 0), cA, voffA); PG8_STAGE(PG8_SA(0, 1), cA + hstep, voffA);
        if (wr == 1) PG8_BAR;
        PG8_WAIT_V(2); PG8_BAR;
        PG8_STAGE(PG8_SB(1, 0), cB + kstep, voffB); PG8_STAGE(PG8_SA(1, 0), cA + kstep, voffA); PG8_STAGE(PG8_SB(1, 1), cB + hstep + kstep, voffB);
        PG8_WAIT_V(6); PG8_BAR;
    } else {
        PG8_STAGE(PG8_SB(0, 0), cB, voffB); PG8_STAGE(PG8_SA(0, 0), cA, voffA); PG8_STAGE(PG8_SB(0, 1), cB + hstep, voffB); PG8_STAGE(PG8_SA(0, 1), cA + hstep, voffA);
        if (wr == 1) PG8_BAR;
        PG8_WAIT_V(4); PG8_BAR;
        PG8_STAGE(PG8_SB(1, 0), cB + kstep, voffB); PG8_STAGE(PG8_SA(1, 0), cA + kstep, voffA); PG8_STAGE(PG8_SB(1, 1), cB + hstep + kstep, voffB);
        PG8_WAIT_V(6); PG8_BAR;
    }
    for (;;) {
        const bool has_next = S.next(ui + 1, nxt);
        const char* nA = has_next ? (const char*)g.A + (size_t)nxt.pm * tstep : cA; const char* nB = has_next ? (const char*)g.Bt + (size_t)nxt.pn * tstep : cB;
        for (int t = 0; t < nt; t += 2) {
            const bool last = (t == nt - 2);
            const char* a1 = cA + (size_t)(t + 1) * kstep;
            const char* a2 = last ? nA : cA + (size_t)(t + 2) * kstep; const char* b2 = last ? nB : cB + (size_t)(t + 2) * kstep;
            const char* a3 = a2 + kstep; const char* b3 = b2 + kstep;
            if (last && has_next) S.a_ready(nxt);
            if constexpr (SP2) {
            PG8_LDB(B0, 0, 0); PG8_LDB(B1, 0, 1); PG8_SCHED; PG8_LDA(At, 0, 0); PG8_STAGE(PG8_SA(1, 1), a1 + hstep, voffA);
            PG8_WAIT_V(8); PG8_WAIT_L(0); PG8_BAR; PG8_MMA(0, 0, At, B0); PG8_MMA(0, 1, At, B1); PG8_BAR; PG8_SCHED;
            PG8_LDA(At, 0, 1); PG8_STAGE(PG8_SB(0, 0), b2, voffB); PG8_STAGE(PG8_SB(0, 1), b2 + hstep, voffB); PG8_STAGE(PG8_SA(0, 0), a2, voffA);
            PG8_WAIT_V(8); PG8_WAIT_L(0); PG8_BAR; PG8_MMA(1, 0, At, B0); PG8_MMA(1, 1, At, B1); PG8_BAR; PG8_SCHED;
            PG8_LDB(B0, 1, 0); PG8_LDB(B1, 1, 1); PG8_SCHED; PG8_LDA(At, 1, 0); PG8_STAGE(PG8_SA(0, 1), a2 + hstep, voffA);
            PG8_WAIT_V(8); PG8_WAIT_L(0); PG8_BAR; PG8_MMA(0, 0, At, B0); PG8_MMA(0, 1, At, B1); PG8_BAR; PG8_SCHED;
            PG8_LDA(At, 1, 1); PG8_STAGE(PG8_SB(1, 0), b3, voffB); PG8_STAGE(PG8_SB(1, 1), b3 + hstep, voffB); PG8_STAGE(PG8_SA(1, 0), a3, voffA);
            PG8_WAIT_V(8); PG8_WAIT_L(0); PG8_BAR; PG8_MMA(1, 0, At, B0); PG8_MMA(1, 1, At, B1); PG8_BAR; PG8_SCHED;
            } else {
            PG8_LDB(B0, 0, 0); PG8_SCHED; PG8_LDA(At, 0, 0); PG8_STAGE(PG8_SA(1, 1), a1 + hstep, voffA);
            PG8_WAIT_L(8); PG8_BAR; PG8_WAIT_L(0); PG8_MMA(0, 0, At, B0); PG8_BAR; PG8_SCHED;
            PG8_LDB(B1, 0, 1); PG8_STAGE(PG8_SB(0, 0), b2, voffB);
            PG8_BAR; PG8_WAIT_L(0); PG8_MMA(0, 1, At, B1); PG8_BAR;
            PG8_LDA(At, 0, 1); PG8_STAGE(PG8_SA(0, 0), a2, voffA);
            PG8_BAR; PG8_WAIT_L(0); PG8_MMA(1, 0, At, B0); PG8_BAR; PG8_SCHED;
            PG8_STAGE(PG8_SB(0, 1), b2 + hstep, voffB);
            PG8_WAIT_V(6); PG8_BAR; PG8_MMA(1, 1, At, B1); PG8_BAR;
            PG8_LDB(B0, 1, 0); PG8_SCHED; PG8_LDA(At, 1, 0); PG8_STAGE(PG8_SA(0, 1), a2 + hstep, voffA);
            PG8_WAIT_L(8); PG8_BAR; PG8_WAIT_L(0); PG8_MMA(0, 0, At, B0); PG8_BAR; PG8_SCHED;
            PG8_LDB(B1, 1, 1); PG8_STAGE(PG8_SB(1, 0), b3, voffB);
            PG8_BAR; PG8_WAIT_L(0); PG8_MMA(0, 1, At, B1); PG8_BAR;
            PG8_LDA(At, 1, 1); PG8_STAGE(PG8_SA(1, 0), a3, voffA);
            PG8_BAR; PG8_WAIT_L(0); PG8_MMA(1, 0, At, B0); PG8_BAR; PG8_SCHED;
            PG8_STAGE(PG8_SB(1, 1), b3 + hstep, voffB);
            PG8_WAIT_V(6); PG8_BAR; PG8_MMA(1, 1, At, B1); PG8_BAR;
            }
        }
        if constexpr (ALIGN_EPI) { if (wr == 0) PG8_BAR; }
        if constexpr (!Epi::AFTER_DRAIN) { E(acc, cur, wr, wc, fr, fq); S.done(cur); }
        if (!has_next) break;
#pragma unroll
        for (int a = 0; a < 2; ++a)
#pragma unroll
            for (int b = 0; b < 2; ++b)
#pragma unroll
                for (int m = 0; m < 4; ++m)
#pragma unroll
                    for (int n = 0; n < 2; ++n) acc[a][b][m][n] = (f32x4){0.f, 0.f, 0.f, 0.f};
        cur = nxt; cA = nA; cB = nB; ++ui;
        if constexpr (ALIGN_EPI) { if (wr == 1) PG8_BAR; }
    }
    PG8_WAIT_V(0);
    if constexpr (!ALIGN_EPI) { if (wr == 0) PG8_BAR; }
    PG8_BAR;
    if constexpr (Epi::AFTER_DRAIN) { E.fused(acc, cur, wr, wc, fr, fq, lds, wid, lane); S.done(cur); }
#undef PG8_SA
#undef PG8_SB
#undef PG8_STAGE
#undef PG8_LDA
#undef PG8_LDB
#undef PG8_MMA
#undef PG8_WAIT_V
#undef PG8_WAIT_L
#undef PG8_BAR
#undef PG8_SCHED
}
}
#define GAS __attribute__((address_space(1)))
#define LAS __attribute__((address_space(3)))
typedef unsigned short bf16;
typedef unsigned v4u __attribute__((ext_vector_type(4)));
typedef float f32x4 __attribute__((ext_vector_type(4)));
typedef short bf16x8 __attribute__((ext_vector_type(8)));
typedef GAS unsigned gu32;
typedef GAS unsigned long long gu64;
#define RLX_AGENT __ATOMIC_RELAXED, __HIP_MEMORY_SCOPE_AGENT
#define LDS_WAIT() asm volatile("s_waitcnt lgkmcnt(0)" ::: "memory")
#define VM_WAIT() asm volatile("s_waitcnt vmcnt(0)" ::: "memory")
__device__ __forceinline__ unsigned long long rt() { return __builtin_amdgcn_s_memrealtime(); }
__device__ __forceinline__ unsigned f2bf(float f) { unsigned u = __builtin_bit_cast(unsigned, f); return (u + 0x7fffu + ((u >> 16) & 1u)) >> 16; }
__device__ __forceinline__ unsigned pk2(float lo, float hi) { return f2bf(lo) | (f2bf(hi) << 16); }
#define XB_TMO      128
#define XB_XCNT(j)  (256  + 64 * (j))
#define XB_XSUB(j)  (1280 + 64 * (j))
#define XB_XGEN(j)  (2304 + 64 * (j))
#define XB_TOP      3328
#define XB_TOPGEN   3392
#define XCD_BAR_WORDS 3456
#define XB_SPIN_CAP (1u << 18)

__device__ __forceinline__ unsigned xb_ld(unsigned* p)              { return __hip_atomic_load(p, __ATOMIC_RELAXED, __HIP_MEMORY_SCOPE_AGENT); }
__device__ __forceinline__ unsigned xb_add(unsigned* p, unsigned v) { return __hip_atomic_fetch_add(p, v, __ATOMIC_RELAXED, __HIP_MEMORY_SCOPE_AGENT); }
__device__ __forceinline__ unsigned xb_xcc_id() { return (unsigned)__builtin_amdgcn_s_getreg((3 << 11) | 20) & 0xFu; }
#define XB_SPIN(cond, bar) do { unsigned _sp = 0; while (cond) { __builtin_amdgcn_s_sleep(1); \
    if ((++_sp & 255u) == 0u) { if (xb_ld(&(bar)[XB_TMO])) break; if (_sp > XB_SPIN_CAP) { atomicAdd(&(bar)[XB_TMO], 1u); break; } } } } while (0)

struct XcdBarrier {
    unsigned* bar; unsigned x;
    volatile LAS unsigned* st;
};

__device__ __forceinline__ XcdBarrier xcd_barrier_post(unsigned* bar, volatile LAS unsigned* st) {
    XcdBarrier b; b.bar = bar; b.x = xb_xcc_id(); b.st = st;
    if (threadIdx.x == 0) (void)xb_add(&bar[XB_XCNT(b.x)], 1u);
    return b;
}
__device__ __forceinline__ void xcd_barrier_complete(unsigned* bar, unsigned x, unsigned& nloc, unsigned& nx) {
    const unsigned G = gridDim.x * gridDim.y * gridDim.z;
    unsigned sum, cnt, mine, sp = 0u;
    for (;;) {
        sum = 0u; cnt = 0u; mine = 0u;
#pragma unroll
        for (unsigned j = 0; j < 16; ++j) { const unsigned c = xb_ld(&bar[XB_XCNT(j)]); sum += c; cnt += (c > 0u) ? 1u : 0u; mine = (j == x) ? c : mine; }
        if (sum == G) break;
        __builtin_amdgcn_s_sleep(1);
        if ((++sp & 255u) == 0u) { if (xb_ld(&bar[XB_TMO])) break; if (sp > XB_SPIN_CAP) { atomicAdd(&bar[XB_TMO], 1u); break; } }
    }
    nloc = mine > 0u ? mine : 1u; nx = cnt > 0u ? cnt : 1u;
}

__device__ __forceinline__ void xcd_barrier(const XcdBarrier& b) {
    asm volatile("s_waitcnt vmcnt(0)" ::: "memory");
    __syncthreads();
    if (threadIdx.x == 0) {
        unsigned* bar = b.bar;
        __builtin_amdgcn_s_waitcnt(0);
        unsigned nloc = b.st[0], nx = b.st[1];
        if (nloc == 0u) { xcd_barrier_complete(bar, b.x, nloc, nx); b.st[0] = nloc; b.st[1] = nx; }
        const unsigned old = xb_add(&bar[XB_XSUB(b.x)], 1u);
        const unsigned gen = old / nloc;
        if (old + 1u == (gen + 1u) * nloc) {
            __builtin_amdgcn_fence(__ATOMIC_RELEASE, "agent");
            asm volatile("s_waitcnt vmcnt(0)" ::: "memory");
            const unsigned og = xb_add(&bar[XB_TOP], 1u);
            const unsigned tg = og / nx;
            if (og + 1u == (tg + 1u) * nx) xb_add(&bar[XB_TOPGEN], 1u);
            else XB_SPIN(xb_ld(&bar[XB_TOPGEN]) == tg, bar);
            __builtin_amdgcn_fence(__ATOMIC_ACQUIRE, "agent");
            xb_add(&bar[XB_XGEN(b.x)], 1u);
            asm volatile("s_waitcnt vmcnt(0)" ::: "memory");
        } else {
            XB_SPIN(xb_ld(&bar[XB_XGEN(b.x)]) == gen, bar);
            __builtin_amdgcn_fence(__ATOMIC_ACQUIRE, "agent");
            asm volatile("s_waitcnt vmcnt(0)" ::: "memory");
        }
    }
    __syncthreads();
}
__device__ __forceinline__ void p0_transpose_item(const float* W, int K, int N, bf16* WT, int row_off, LAS float* scr, int item, int lane) {
    const int nblk = N / 32, kb = item / nblk, nb = item % nblk, k0 = 64 * kb, n0 = 32 * nb;
#pragma unroll 8
    for (int i = 0; i < 32; ++i) { const int kk = 2 * i + (lane >> 5); scr[kk * 33 + (lane & 31)] = W[(size_t)(k0 + kk) * N + n0 + (lane & 31)]; }
    LDS_WAIT(); asm volatile("" ::: "memory");
    const int c = lane & 7;
#pragma unroll
    for (int j = 0; j < 4; ++j) { const int n = (lane >> 3) + 8 * j; const LAS float* s = scr + (8 * c) * 33 + n;
        v4u o; o.x = pk2(s[0 * 33], s[1 * 33]); o.y = pk2(s[2 * 33], s[3 * 33]); o.z = pk2(s[4 * 33], s[5 * 33]); o.w = pk2(s[6 * 33], s[7 * 33]);
        *(GAS v4u*)(WT + (size_t)(row_off + n0 + n) * K + k0 + 8 * c) = o; }
    LDS_WAIT(); asm volatile("" ::: "memory");
}
namespace pg8 {
typedef unsigned u32x2 __attribute__((ext_vector_type(2)));
struct EpiF32 {
    static constexpr bool PERM = false, AFTER_DRAIN = false;
    float* C; int ldc;
    __device__ __forceinline__ void operator()(const f32x4 (&acc)[2][2][4][2], const Unit& u, int wr, int wc, int fr, int fq) const {
        const int row0 = u.pm * BM + wr * 64 + fr, col0 = u.pn * BM + wc * 32 + 4 * fq;
#pragma unroll
        for (int ai = 0; ai < 2; ++ai)
#pragma unroll
            for (int m = 0; m < 4; ++m) { float* rowp = C + (size_t)(row0 + ai * HALF + m * 16) * ldc + col0;
#pragma unroll
                for (int bj = 0; bj < 2; ++bj)
#pragma unroll
                    for (int n = 0; n < 2; ++n) *(f32x4*)(rowp + bj * HALF + n * 16) = acc[ai][bj][m][n]; }
    }
};
struct EpiRelu2 {
    static constexpr bool PERM = true, AFTER_DRAIN = false;
    bf16_t* O; int ldc;
    __device__ __forceinline__ void operator()(const f32x4 (&acc)[2][2][4][2], const Unit& u, int wr, int wc, int fr, int fq) const {
        const int row0 = u.pm * BM + wr * 64 + fr, col0 = u.pn * BM + wc * 32 + 8 * fq;
#pragma unroll
        for (int ai = 0; ai < 2; ++ai)
#pragma unroll
            for (int m = 0; m < 4; ++m) { bf16_t* rowp = O + (size_t)(row0 + ai * HALF + m * 16) * ldc + col0;
#pragma unroll
                for (int bj = 0; bj < 2; ++bj) { f32x4 v0 = acc[ai][bj][m][0], v1 = acc[ai][bj][m][1];
                    v0 = __builtin_elementwise_max(v0, (f32x4){0.f, 0.f, 0.f, 0.f}); v1 = __builtin_elementwise_max(v1, (f32x4){0.f, 0.f, 0.f, 0.f});
                    v0 = v0 * v0; v1 = v1 * v1;
                    u32x4 w; w.x = cvt_pk_bf16(v0[0], v0[1]); w.y = cvt_pk_bf16(v0[2], v0[3]); w.z = cvt_pk_bf16(v1[0], v1[1]); w.w = cvt_pk_bf16(v1[2], v1[3]);
                    *(u32x4*)(rowp + bj * HALF) = w; } }
    }
};
struct EpiIn {
    static constexpr bool PERM = false, AFTER_DRAIN = false;
    bf16_t* P; float* out_na; float* out_swa; float* out_diff; const float* rope_c; const float* rope_s; int layer;
    __device__ __forceinline__ void operator()(const f32x4 (&acc)[2][2][4][2], const Unit& u, int wr, int wc, int fr, int fq) const {
        const int pn = u.pn, pm = u.pm; const bool lat = pm >= 16;
        const int row0 = pm * BM + wr * 64 + fr;
#pragma unroll
        for (int bj = 0; bj < 2; ++bj) {
            const int cg = pn * BM + bj * HALF + wc * 32;
            const bool roped = lat && (pn == 12 || pn == 13 || pn == 15 || pn == 16 || pn == 17 || pn == 18 || (pn == 14 && bj == 0));
            float* kvout = nullptr; int kvld = 512;
            if (!lat) {
                const size_t bl = (size_t)(pm * 4 + layer) * 2;
                if (pn == 2 || pn == 3)        kvout = out_na + (bl + 0) * 131072 + (pn - 2) * 256 + bj * HALF + wc * 32;
                else if (pn == 4 || pn == 5)   kvout = out_na + (bl + 1) * 131072 + (pn - 4) * 256 + bj * HALF + wc * 32;
                else if (pn == 14)           { kvout = out_swa + (bl + bj) * 32768 + wc * 32; kvld = 128; }
                else if (pn == 17 || pn == 18) kvout = out_diff + (bl + 0) * 131072 + (pn - 17) * 256 + bj * HALF + wc * 32;
                else if (pn == 19 || pn == 20) kvout = out_diff + (bl + 1) * 131072 + (pn - 19) * 256 + bj * HALF + wc * 32;
            }
#pragma unroll
            for (int ai = 0; ai < 2; ++ai)
#pragma unroll
                for (int m = 0; m < 4; ++m) {
                    const int row = row0 + ai * HALF + m * 16;
                    f32x4 v0 = acc[ai][bj][m][0], v1 = acc[ai][bj][m][1];
                    if (roped) {
                        const int t = (row - 4096) & 2047; const int pos = (wc & 1) ? (t & 63) : (t >> 6);
                        const f32x4 cv = *(const f32x4*)(rope_c + pos * 16 + 4 * fq), sv = *(const f32x4*)(rope_s + pos * 16 + 4 * fq);
                        const f32x4 o0 = v0 * cv - v1 * sv, o1 = v0 * sv + v1 * cv; v0 = o0; v1 = o1;
                    }
                    u32x2 w0, w1; w0.x = cvt_pk_bf16(v0[0], v0[1]); w0.y = cvt_pk_bf16(v0[2], v0[3]); w1.x = cvt_pk_bf16(v1[0], v1[1]); w1.y = cvt_pk_bf16(v1[2], v1[3]);
                    bf16_t* pp = P + (size_t)row * 5376 + cg + 4 * fq;
                    *(u32x2*)pp = w0; *(u32x2*)(pp + 16) = w1;
                    if (kvout) { float* d = kvout + (size_t)(row - pm * BM) * kvld + 4 * fq; *(f32x4*)d = v0; *(f32x4*)(d + 16) = v1; }
                }
        }
    }
};
}

namespace mx {
typedef short s16x4 __attribute__((ext_vector_type(4)));
typedef float f32x16 __attribute__((ext_vector_type(16)));
typedef unsigned u32x2 __attribute__((ext_vector_type(2)));
typedef float f32x2_t __attribute__((ext_vector_type(2)));
typedef __bf16 bf16x2_t __attribute__((ext_vector_type(2)));
constexpr float LOG2E = 1.4426950408889634f;
constexpr float CS = 0.125f * LOG2E;
constexpr int NP = 5376;
constexpr float NEG_INF = -__builtin_huge_valf();
#define MX_DI __device__ __forceinline__
#define MX_MFMA(a, b, c) __builtin_amdgcn_mfma_f32_32x32x16_bf16((a), (b), (c), 0, 0, 0)
MX_DI unsigned cvtpk(float lo, float hi) { f32x2_t v = {lo, hi}; bf16x2_t b = __builtin_convertvector(v, bf16x2_t); return __builtin_bit_cast(unsigned, b); }
MX_DI float xhalf(float v) { return __shfl_xor(v, 32); }
MX_DI float wsum(float v) {
#pragma unroll
    for (int o = 1; o < 64; o <<= 1) v += __shfl_xor(v, o);
    return v;
}
MX_DI int crow(int reg, int h) { return (reg & 3) + 8 * (reg >> 2) + 4 * h; }
template <int S> MX_DI bf16x8 pack8(const f32x16& x) {
    v4u p; p.x = cvtpk(x[8 * S + 0], x[8 * S + 1]); p.y = cvtpk(x[8 * S + 2], x[8 * S + 3]); p.z = cvtpk(x[8 * S + 4], x[8 * S + 5]); p.w = cvtpk(x[8 * S + 6], x[8 * S + 7]);
    return __builtin_bit_cast(bf16x8, p);
}
MX_DI s16x4 vtr(const LAS unsigned char* p) { typedef short v4i16_t __attribute__((ext_vector_type(4))); return __builtin_bit_cast(s16x4, __builtin_amdgcn_ds_read_tr16_b64_v4i16((LAS v4i16_t*)p)); }

template <int NG> struct KF { bf16x8 f[NG][4]; };
template <int NG> MX_DI void load_kf(KF<NG>& k, const bf16* kbase, int kp, int pos0, int hi_, int r, int h) {
#pragma unroll
    for (int g = 0; g < NG; ++g) {
        const int pos = pos0 + 32 * g + r;
        const bf16* kr = kbase + (size_t)pos * kp + 8 * h;
#pragma unroll
        for (int ds = 0; ds < 4; ++ds) k.f[g][ds] = *(const bf16x8*)(kr + 16 * ds);
    }
}
MX_DI f32x16 qk_group(const bf16x8 (&kf)[4], const bf16x8 (&qf)[4]) {
    f32x16 a;
#pragma unroll
    for (int i = 0; i < 16; ++i) a[i] = 0.f;
    a = MX_MFMA(kf[0], qf[0], a); a = MX_MFMA(kf[1], qf[1], a); a = MX_MFMA(kf[2], qf[2], a); a = MX_MFMA(kf[3], qf[3], a);
    return a;
}
template <int DV, int KT> struct VF { v4u f[KT * DV * 2 / 1024]; };
template <int DV, int KT> MX_DI void load_vf(VF<DV, KT>& v, const bf16* vbase, int vp, int pos0, int hi_, int lane) {
    constexpr int CPR = DV / 8, NI = KT * DV * 2 / 1024;
#pragma unroll
    for (int i = 0; i < NI; ++i) {
        const int c = 64 * i + lane, row = c / CPR, chp = c % CPR;
        const int pos = pos0 + row;
        v.f[i] = *(const v4u*)(vbase + (size_t)pos * vp + chp * 8);
    }
}
template <int DV, int KT> MX_DI void store_vf(const VF<DV, KT>& v, LAS unsigned char* vimg, int lane) {
    constexpr int CPR = DV / 8, NI = KT * DV * 2 / 1024;
#pragma unroll
    for (int i = 0; i < NI; ++i) {
        const int c = 64 * i + lane, row = c / CPR, chp = c % CPR;
        const int sw = (DV == 64) ? (((row >> 1) & 1) << 2) : ((row & 3) << 2);
        *(LAS v4u*)(vimg + row * (DV * 2) + ((chp ^ sw) * 16)) = v.f[i];
    }
}
template <int DV, int KT> MX_DI void pv_tile(f32x16 (&o)[DV / 32], const bf16x8 (&pf)[KT / 32][2], const LAS unsigned char* vimg, int lane) {
    constexpr int RS = DV * 2, NDB = DV / 32, NKS = KT / 16;
    const int h = lane >> 5, blk = (lane >> 4) & 1, q = (lane >> 2) & 3, p = lane & 3;
    const int sq = (DV == 64) ? ((q >> 1) & 1) : q;
    const unsigned tb = (unsigned)(uintptr_t)vimg + (4 * h + q) * RS + (2 * blk + (p >> 1)) * 16 + (p & 1) * 8;
    unsigned ab[NDB];
#pragma unroll
    for (int db = 0; db < NDB; ++db) ab[db] = tb + ((db ^ sq) * 64);
    asm volatile("s_waitcnt lgkmcnt(0)" ::: "memory");
#pragma unroll
    for (int kh = 0; kh < NKS; kh += 2) {
        s16x4 lo[2][NDB], hi[2][NDB];
#pragma unroll
        for (int k2 = 0; k2 < 2; ++k2)
#pragma unroll
            for (int db = 0; db < NDB; ++db) {
                asm volatile("ds_read_b64_tr_b16 %0, %1 offset:%c2" : "=&v"(lo[k2][db]) : "v"(ab[db]), "i"((kh + k2) * 16 * RS) : "memory");
                asm volatile("ds_read_b64_tr_b16 %0, %1 offset:%c2" : "=&v"(hi[k2][db]) : "v"(ab[db]), "i"((kh + k2) * 16 * RS + 8 * RS) : "memory");
            }
        asm volatile("s_waitcnt lgkmcnt(0)" ::: "memory");
        __builtin_amdgcn_sched_barrier(0);
#pragma unroll
        for (int k2 = 0; k2 < 2; ++k2)
#pragma unroll
            for (int db = 0; db < NDB; ++db) {
                const bf16x8 va = __builtin_shufflevector(lo[k2][db], hi[k2][db], 0, 1, 2, 3, 4, 5, 6, 7);
                o[db] = MX_MFMA(va, pf[(kh + k2) >> 1][(kh + k2) & 1], o[db]);
            }
        __builtin_amdgcn_sched_barrier(0);
    }
}

struct Seq { const bf16* Kc; const bf16* Vc; int pc, ntc; const bf16* Kl; const bf16* Vl; int pl, ntl, lstart, llen; };
template <int DV, int KT, int MODE> struct Attn {
    static constexpr int NG = KT / 32;
    const bf16x8 (&qf)[4]; const Seq& q; int qa, qb; const LAS float* rpb; LAS unsigned char* img0; int lane, r, h;
    f32x16 (&o)[DV / 32]; float& m; float& l;
    MX_DI void tile_src(int t, const bf16*& kb, const bf16*& vb, int& kp, int& pos0, int& hi_, bool& isc) const {
        isc = t < q.ntc; kb = isc ? q.Kc : q.Kl; vb = isc ? q.Vc : q.Vl; kp = isc ? q.pc : q.pl; pos0 = isc ? KT * t : q.lstart + KT * (t - q.ntc); hi_ = isc ? 255 : q.llen - 1;
    }
    MX_DI void request_k(int t, KF<NG>& k) const { int ln = lane; asm volatile("" : "+v"(ln)); const int r = ln & 31, h = ln >> 5; const bf16* kb; const bf16* vb; int kp, pos0, hi_; bool isc; tile_src(t, kb, vb, kp, pos0, hi_, isc); load_kf<NG>(k, kb, kp, pos0, hi_, r, h); }
    MX_DI void request_v(int t, VF<DV, KT>& v) const { int lane = this->lane; asm volatile("" : "+v"(lane)); const bf16* kb; const bf16* vb; int kp, pos0, hi_; bool isc; tile_src(t, kb, vb, kp, pos0, hi_, isc); load_vf<DV, KT>(v, vb, kp, pos0, hi_, lane); }
    template <bool PRE> MX_DI void step(int t, KF<NG>& k, VF<DV, KT>& vn, LAS unsigned char* icur, LAS unsigned char* inxt) const {
        if (PRE) { request_v(t + 1, vn); asm volatile("" ::: "memory"); }
        int lane = this->lane; asm volatile("" : "+v"(lane)); const int h = lane >> 5;
        const bf16* kb; const bf16* vb; int kp, pos0, hi_; bool isc; tile_src(t, kb, vb, kp, pos0, hi_, isc);
        f32x16 s[NG];
#pragma unroll
        for (int g = 0; g < NG; ++g) s[g] = qk_group(k.f[g], qf);
        if (PRE) { asm volatile("" ::: "memory"); request_k(t + 1, k); asm volatile("" ::: "memory"); }
        float mxv = NEG_INF;
#pragma unroll
        for (int g = 0; g < NG; ++g) {
#pragma unroll
            for (int i = 0; i < 16; ++i) {
                const int kk = 32 * g + crow(i, h);
                float tv = s[g][i] * CS;
                if (MODE == 1) { if (!isc) { const int kpos = pos0 + kk; const int d = qa - kpos; const bool ok = (kpos >= 0) && (kpos < q.llen) && (d <= 128) && (d >= -128); tv = ok ? tv : NEG_INF; } }
                if (MODE == 2) { if (!isc) { const int kc = kk, krow = pos0 >> 6; int cs = qa - 8; cs = cs < 0 ? 0 : (cs > 48 ? 48 : cs); const bool ok = (kc >= cs) && (kc < cs + 16);
                        const int idx = ok ? ((krow - qb + 7) * 31 + (kc - qa + 15)) : 0; const float bias = rpb[idx]; tv = ok ? tv + bias : NEG_INF; } }
                s[g][i] = tv; mxv = fmaxf(mxv, tv);
            }
        }
        mxv = fmaxf(mxv, xhalf(mxv));
        const float mnew = fmaxf(m, mxv), alpha = __builtin_amdgcn_exp2f(m - mnew); m = mnew;
        float ls = 0.f;
#pragma unroll
        for (int g = 0; g < NG; ++g)
#pragma unroll
            for (int i = 0; i < 16; ++i) { const float pv_ = __builtin_amdgcn_exp2f(s[g][i] - mnew); s[g][i] = pv_; ls += pv_; }
        l = l * alpha + ls;
#pragma unroll
        for (int db = 0; db < DV / 32; ++db)
#pragma unroll
            for (int i = 0; i < 16; ++i) o[db][i] *= alpha;
        bf16x8 pf[NG][2];
#pragma unroll
        for (int g = 0; g < NG; ++g) { pf[g][0] = pack8<0>(s[g]); pf[g][1] = pack8<1>(s[g]); }
        pv_tile<DV, KT>(o, pf, icur, lane);
        if (PRE) { asm volatile("" ::: "memory"); store_vf<DV, KT>(vn, inxt, lane); }
    }
    MX_DI void run() const {
        const int nt = q.ntc + q.ntl;
        KF<NG> K; VF<DV, KT> V; LAS unsigned char* img1 = img0 + 8192;
        asm volatile("s_waitcnt lgkmcnt(0)" ::: "memory");
        request_v(0, V); request_k(0, K); store_vf<DV, KT>(V, img0, lane); asm volatile("" ::: "memory");
        int t = 0;
        for (; t + 2 < nt; t += 2) { step<true>(t, K, V, img0, img1); step<true>(t + 1, K, V, img1, img0); }
        if (nt - t == 2) { step<true>(t, K, V, img0, img1); step<false>(t + 1, K, V, img1, img0); }
        else step<false>(t, K, V, img0, img1);
    }
};

template <int MODE>
MX_DI void attn64(const bf16* qrow, const Seq& sq, int qa, int qb, const LAS float* rpb, bool has_sink, float sink, LAS unsigned char* vimg, bf16* outp, int lane) {
    const int r = lane & 31, h = lane >> 5;
    bf16x8 qf[4];
#pragma unroll
    for (int ds = 0; ds < 4; ++ds) qf[ds] = *(const bf16x8*)(qrow + 16 * ds + 8 * h);
    f32x16 o[2];
#pragma unroll
    for (int i = 0; i < 16; ++i) { o[0][i] = 0.f; o[1][i] = 0.f; }
    float m = NEG_INF, l = 0.f;
    Attn<64, 64, MODE> at{qf, sq, qa, qb, rpb, vimg, lane, r, h, o, m, l};
    at.run();
    l += xhalf(l);
    if (has_sink) l += __builtin_amdgcn_exp2f(sink * LOG2E - m);
    const float inv = 1.0f / l;
#pragma unroll
    for (int db = 0; db < 2; ++db)
#pragma unroll
        for (int g4 = 0; g4 < 4; ++g4) {
            u32x2 w; w.x = cvtpk(o[db][4 * g4 + 0] * inv, o[db][4 * g4 + 1] * inv); w.y = cvtpk(o[db][4 * g4 + 2] * inv, o[db][4 * g4 + 3] * inv);
            *(u32x2*)(outp + 32 * db + 8 * g4 + 4 * h) = w;
        }
}
MX_DI void attn_dpart(const bf16* qrow, const Seq& sq, LAS unsigned char* vimg, float* dp  , float* dstat  , int lane) {
    const int r = lane & 31, h = lane >> 5;
    bf16x8 qf[4];
#pragma unroll
    for (int ds = 0; ds < 4; ++ds) qf[ds] = *(const bf16x8*)(qrow + 16 * ds + 8 * h);
    f32x16 o[4];
#pragma unroll
    for (int db = 0; db < 4; ++db)
#pragma unroll
        for (int i = 0; i < 16; ++i) o[db][i] = 0.f;
    float m = NEG_INF, l = 0.f;
    Attn<128, 32, 0> at{qf, sq, 0, 0, nullptr, vimg, lane, r, h, o, m, l};
    at.run();
    l += xhalf(l);
    const float inv = 1.0f / l;
#pragma unroll
    for (int db = 0; db < 4; ++db)
#pragma unroll
        for (int g4 = 0; g4 < 4; ++g4) {
            const f32x4 v = {o[db][4 * g4 + 0] * inv, o[db][4 * g4 + 1] * inv, o[db][4 * g4 + 2] * inv, o[db][4 * g4 + 3] * inv};
            *(f32x4*)(dp + 32 * db + 8 * g4 + 4 * h) = v;
        }
    if (h == 0) { f32x2_t st = {m, l}; *(f32x2_t*)dstat = st; }
}

MX_DI float bf2f(short b) { return __uint_as_float(((unsigned)(unsigned short)b) << 16); }
MX_DI void conv_unit(const bf16* P, bf16* MIX, const float* cw, int r0, int seg0, int seg1, int lane) {
    const int c0 = 8 * lane;
    float w0[8], w1[8], w2[8];
#pragma unroll
    for (int e = 0; e < 8; ++e) { w0[e] = cw[c0 + e]; w1[e] = cw[512 + c0 + e]; w2[e] = cw[1024 + c0 + e]; }
    float zp[8], zc[8], zn[8];
    {
        const int rp = r0 - 1; const bool okp = rp >= seg0; const int rpc = okp ? rp : r0;
        const bf16x8 u = *(const bf16x8*)(P + (size_t)rpc * NP + 1536 + c0), gc = *(const bf16x8*)(P + (size_t)rpc * NP + 2560 + c0);
#pragma unroll
        for (int e = 0; e < 8; ++e) zp[e] = okp ? bf2f(u[e]) * bf2f(gc[e]) : 0.f;
        const bf16x8 u1 = *(const bf16x8*)(P + (size_t)r0 * NP + 1536 + c0), gc1 = *(const bf16x8*)(P + (size_t)r0 * NP + 2560 + c0);
#pragma unroll
        for (int e = 0; e < 8; ++e) zc[e] = bf2f(u1[e]) * bf2f(gc1[e]);
    }
    for (int i = 0; i < 16; ++i) {
        const int row = r0 + i, rn = row + 1; const bool okn = rn < seg1; const int rnc = okn ? rn : row;
        const bf16x8 u = *(const bf16x8*)(P + (size_t)rnc * NP + 1536 + c0), gc = *(const bf16x8*)(P + (size_t)rnc * NP + 2560 + c0);
        const bf16x8 gb = *(const bf16x8*)(P + (size_t)row * NP + 2048 + c0);
#pragma unroll
        for (int e = 0; e < 8; ++e) zn[e] = okn ? bf2f(u[e]) * bf2f(gc[e]) : 0.f;
        float y[8];
#pragma unroll
        for (int e = 0; e < 8; ++e) y[e] = bf2f(gb[e]) * (w0[e] * zp[e] + w1[e] * zc[e] + w2[e] * zn[e]);
        v4u w; w.x = cvtpk(y[0], y[1]); w.y = cvtpk(y[2], y[3]); w.z = cvtpk(y[4], y[5]); w.w = cvtpk(y[6], y[7]);
        *(v4u*)(MIX + (size_t)row * 2048 + 512 + c0) = w;
#pragma unroll
        for (int e = 0; e < 8; ++e) { zp[e] = zc[e]; zc[e] = zn[e]; }
    }
}

struct MixArgs { const bf16* P; bf16* MIX; const bf16* cna; const bf16* cswa; const bf16* cdiff; const float* conv_w; const float* rpb; const float* sink; float* DP; float* DS; int layer; };
constexpr int U_LDIFF = 2048, U_LNA = 1024, U_LSWA = 1024, U_CDIFF = 1024, U_CMHA = 1024, U_CGQA = 1024, U_CONV = 512;
constexpr int NUNITS = U_LDIFF + U_LNA + U_LSWA + U_CDIFF + U_CMHA + U_CGQA + U_CONV;
MX_DI int fresh(int v) { asm volatile("" : "+v"(v)); return v; }
MX_DI void mix_unit(const MixArgs& A, int u, LAS unsigned char* vimg, LAS float* aux, int lane_in) {
    const int l = A.layer;
    if (u < U_LDIFF) {
        const int lane = fresh(lane_in), r = lane & 31;
        const int part = u & 3, hh = (u >> 2) & 3, rb = u >> 4, b = rb >> 6, q0 = (rb & 63) * 32, br = part >> 1, kh = part & 1;
        const size_t lrow0 = 4096 + (size_t)b * 2048, row = lrow0 + q0 + r;
        const bf16* cd = A.cdiff + (size_t)((b * 4 + l) * 2) * 256 * 512;
        Seq sq{cd + 128 * hh + 64 * br, cd + 256 * 512 + 128 * hh, 512, kh == 0 ? 8 : 0,
               A.P + lrow0 * NP + 4352 + 128 * hh + 64 * br, A.P + lrow0 * NP + 4864 + 128 * hh, NP, kh == 0 ? 28 : 36, kh == 0 ? 0 : 896, 2048};
        attn_dpart(A.P + row * NP + 3840 + 128 * hh + 64 * br, sq, vimg, A.DP + ((row * 4 + hh) * 4 + part) * 128, A.DS + ((row * 4 + hh) * 4 + part) * 2, lane);
        return;
    }
    u -= U_LDIFF;
    if (u < U_LNA) {
        const int lane = fresh(lane_in), r = lane & 31;
        const int rb = u >> 3, hh = u & 7, b = rb >> 6, t0 = (rb & 63) * 32;
        const size_t lrow0 = 4096 + (size_t)b * 2048;
        const int qr = t0 >> 6, qc = (t0 & 63) + r; int kr0 = qr - 4; kr0 = kr0 < 0 ? 0 : (kr0 > 24 ? 24 : kr0);
        const bf16* cn = A.cna + (size_t)((b * 4 + l) * 2) * 256 * 512;
        asm volatile("s_waitcnt lgkmcnt(0)" ::: "memory");
#pragma unroll
        for (int j = 0; j < 8; ++j) { const int e = lane + 64 * j; if (e < 465) aux[e] = A.rpb[hh * 465 + e] * LOG2E; }
        asm volatile("s_waitcnt vmcnt(0) lgkmcnt(0)" ::: "memory");
        Seq sq{cn + 64 * hh, cn + 256 * 512 + 64 * hh, 512, 4, A.P + lrow0 * NP + 512 + 64 * hh, A.P + lrow0 * NP + 1024 + 64 * hh, NP, 8, kr0 * 64, 2048};
        attn64<2>(A.P + (lrow0 + t0 + r) * NP + 0 + 64 * hh, sq, qc, qr, aux, false, 0.f, vimg, A.MIX + (lrow0 + t0 + r) * 2048 + 0 + 64 * hh, lane);
        return;
    }
    u -= U_LNA;
    if (u < U_LSWA) {
        const int lane = fresh(lane_in), r = lane & 31;
        const int rb = u >> 3, hq = u & 7, kvh = hq >> 2, b = rb >> 6, q0 = (rb & 63) * 32;
        const size_t lrow0 = 4096 + (size_t)b * 2048;
        const bf16* cs = A.cswa + (size_t)((b * 4 + l) * 2) * 256 * 128;
        int ls0 = (q0 & ~63) - 128, ls1 = ls0 + 320; ls0 = ls0 < 0 ? 0 : ls0; ls1 = ls1 > 2048 ? 2048 : ls1;
        Seq sq{cs + 64 * kvh, cs + 256 * 128 + 64 * kvh, 128, 4, A.P + lrow0 * NP + 3584 + 64 * kvh, A.P + lrow0 * NP + 3712 + 64 * kvh, NP, (ls1 - ls0) >> 6, ls0, 2048};
        attn64<1>(A.P + (lrow0 + q0 + r) * NP + 3072 + 64 * hq, sq, q0 + r, 0, nullptr, true, A.sink[hq], vimg, A.MIX + (lrow0 + q0 + r) * 2048 + 1024 + 64 * hq, lane);
        return;
    }
    u -= U_LSWA;
    if (u < U_CDIFF) {
        const int lane = fresh(lane_in), r = lane & 31;
        const int br = u & 1, hh = (u >> 1) & 3, rb = u >> 3, b = rb >> 3, q0 = (rb & 7) * 32;
        const size_t crow0 = (size_t)b * 256, row = crow0 + q0 + r;
        Seq sq{nullptr, nullptr, 0, 0, A.P + crow0 * NP + 4352 + 128 * hh + 64 * br, A.P + crow0 * NP + 4864 + 128 * hh, NP, 8, 0, 256};
        attn_dpart(A.P + row * NP + 3840 + 128 * hh + 64 * br, sq, vimg, A.DP + ((row * 4 + hh) * 4 + br) * 128, A.DS + ((row * 4 + hh) * 4 + br) * 2, lane);
        return;
    }
    u -= U_CDIFF;
    if (u < U_CMHA) {
        const int lane = fresh(lane_in), r = lane & 31;
        const int rb = u >> 3, hh = u & 7, b = rb >> 3, q0 = (rb & 7) * 32;
        const size_t crow0 = (size_t)b * 256;
        Seq sq{nullptr, nullptr, 0, 0, A.P + crow0 * NP + 512 + 64 * hh, A.P + crow0 * NP + 1024 + 64 * hh, NP, 4, 0, 256};
        attn64<0>(A.P + (crow0 + q0 + r) * NP + 0 + 64 * hh, sq, 0, 0, nullptr, false, 0.f, vimg, A.MIX + (crow0 + q0 + r) * 2048 + 0 + 64 * hh, lane);
        return;
    }
    u -= U_CMHA;
    if (u < U_CGQA) {
        const int lane = fresh(lane_in), r = lane & 31;
        const int rb = u >> 3, hq = u & 7, kvh = hq >> 2, b = rb >> 3, q0 = (rb & 7) * 32;
        const size_t crow0 = (size_t)b * 256;
        Seq sq{nullptr, nullptr, 0, 0, A.P + crow0 * NP + 3584 + 64 * kvh, A.P + crow0 * NP + 3712 + 64 * kvh, NP, 4, 0, 256};
        attn64<0>(A.P + (crow0 + q0 + r) * NP + 3072 + 64 * hq, sq, 0, 0, nullptr, true, A.sink[hq], vimg, A.MIX + (crow0 + q0 + r) * 2048 + 1024 + 64 * hq, lane);
        return;
    }
    u -= U_CGQA;
    {
        const int lane = fresh(lane_in);
        const int r0 = u * 16; int seg0, seg1;
        if (r0 < 4096) { seg0 = r0 & ~255; seg1 = seg0 + 256; } else { seg0 = 4096 + ((r0 - 4096) & ~2047); seg1 = seg0 + 2048; }
        conv_unit(A.P, A.MIX, A.conv_w, r0, seg0, seg1, lane);
    }
}
MX_DI void diff_combine(const float* DP, const float* DS, bf16* MIX, const float* dg, float lam, float one_m_li, int row, int lane) {
    const int hh = lane >> 4, d0 = (lane & 15) * 8;
    const float* dp = DP + ((size_t)(row * 4 + hh) * 4) * 128 + d0; const float* ds = DS + ((size_t)(row * 4 + hh) * 4) * 2;
    f32x4 o1a, o1b, o2a, o2b;
    if (row >= 4096) {
        const f32x4 st0 = *(const f32x4*)ds, st1 = *(const f32x4*)(ds + 4);
        { const float mm = fmaxf(st0[0], st0[2]), wa = st0[1] * __builtin_amdgcn_exp2f(st0[0] - mm), wb = st0[3] * __builtin_amdgcn_exp2f(st0[2] - mm), iw = 1.0f / (wa + wb);
          const float ca = wa * iw, cb = wb * iw;
          o1a = *(const f32x4*)(dp) * ca + *(const f32x4*)(dp + 128) * cb; o1b = *(const f32x4*)(dp + 4) * ca + *(const f32x4*)(dp + 128 + 4) * cb; }
        { const float mm = fmaxf(st1[0], st1[2]), wa = st1[1] * __builtin_amdgcn_exp2f(st1[0] - mm), wb = st1[3] * __builtin_amdgcn_exp2f(st1[2] - mm), iw = 1.0f / (wa + wb);
          const float ca = wa * iw, cb = wb * iw;
          o2a = *(const f32x4*)(dp + 256) * ca + *(const f32x4*)(dp + 384) * cb; o2b = *(const f32x4*)(dp + 256 + 4) * ca + *(const f32x4*)(dp + 384 + 4) * cb; }
    } else {
        o1a = *(const f32x4*)(dp); o1b = *(const f32x4*)(dp + 4); o2a = *(const f32x4*)(dp + 128); o2b = *(const f32x4*)(dp + 128 + 4);
    }
    const f32x4 ca = o1a - o2a * lam, cb = o1b - o2b * lam;
    float ss = (ca[0] * ca[0] + ca[1] * ca[1]) + (ca[2] * ca[2] + ca[3] * ca[3]) + (cb[0] * cb[0] + cb[1] * cb[1]) + (cb[2] * cb[2] + cb[3] * cb[3]);
    ss += __shfl_xor(ss, 1); ss += __shfl_xor(ss, 2); ss += __shfl_xor(ss, 4); ss += __shfl_xor(ss, 8);
    const float rs = one_m_li / sqrtf(ss * (1.0f / 128.0f) + 1e-6f);
    const f32x4 g0 = *(const f32x4*)(dg + d0), g1 = *(const f32x4*)(dg + d0 + 4);
    v4u w; w.x = cvtpk(ca[0] * rs * g0[0], ca[1] * rs * g0[1]); w.y = cvtpk(ca[2] * rs * g0[2], ca[3] * rs * g0[3]); w.z = cvtpk(cb[0] * rs * g1[0], cb[1] * rs * g1[1]); w.w = cvtpk(cb[2] * rs * g1[2], cb[3] * rs * g1[3]);
    *(v4u*)(MIX + (size_t)row * 2048 + 1536 + 128 * hh + d0) = w;
}
}

constexpr int NWAVES = 8;
constexpr int D = 2048, NTOK = 8192, NCTX = 4096, NIN = 5376, FF = 8192, DEPTH = 4;
constexpr size_t MiB = 1u << 20;
constexpr size_t WS_CTL = 0, CTL_ZERO_BYTES = 1 * MiB;
constexpr size_t WS_ROPE = 1 * MiB;
constexpr size_t WS_MOD = 2 * MiB;
constexpr size_t WS_MODP = 4 * MiB;
constexpr size_t WS_CNA = 10 * MiB, WS_CSWA = 14 * MiB, WS_CDIFF = 15 * MiB;
constexpr size_t WS_WIN = 32 * MiB, WS_WOUT = 116 * MiB, WS_W1 = 148 * MiB, WS_W2 = 276 * MiB;
constexpr size_t WS_H = 404 * MiB, WS_P = 436 * MiB, WS_MIX = 520 * MiB, WS_Y = 552 * MiB, WS_F = 616 * MiB, WS_END = 744 * MiB;
constexpr int CW_BAR = 4096;
constexpr int CW_Q = 16384;
static_assert((CW_Q + 64 * 8) * 4 <= (int)CTL_ZERO_BYTES && CW_BAR + XCD_BAR_WORDS <= CW_Q, "ctl map");
constexpr size_t OUT_YS = 8388608, OUT_NA = 16777216, OUT_SWA = 33554432, OUT_DIFF = 37748736, OUT_TOTAL = 54525952;
constexpr int RING_BYTES = 131072, MISC_OFF = RING_BYTES + 320, AUX_OFF = RING_BYTES + 1024, AUX_BYTES = 1920, LDS_BYTES = 147456;
static_assert(AUX_OFF + 8 * AUX_BYTES <= LDS_BYTES, "lds map");
constexpr size_t WS_DP = WS_F, WS_DS = WS_F + 64 * MiB;
constexpr float RMS_EPS = 1e-6f;

struct Args { const float* in[19]; float* out; unsigned char* ws; float lam_init[4]; };
typedef const __attribute__((address_space(4))) Args* ArgsP;
__device__ __forceinline__ ArgsP get_args() { ArgsP p = (ArgsP)__builtin_amdgcn_kernarg_segment_ptr(); asm volatile("" : "+s"(p)); return p; }

__device__ __forceinline__ float wave_sum(float v) {
#pragma unroll
    for (int o = 1; o < 64; o <<= 1) v += __shfl_xor(v, o);
    return v;
}
__device__ __forceinline__ const float* mod_row(const float* MOD, int l, int v, int i) { return MOD + ((size_t)(l * 3 + v) * 6 + i) * D; }
__device__ __forceinline__ int row_vec(int row) { return row < NCTX ? 0 : 1 + ((row - NCTX) >> 11); }

__device__ __forceinline__ void norm_mod_store(const f32x4 (&x)[8], const float* g, const float* ms, const float* mb, bf16* orow, int lane) {
    float ss = 0.f;
#pragma unroll
    for (int j = 0; j < 8; ++j) ss += (x[j].x * x[j].x + x[j].y * x[j].y) + (x[j].z * x[j].z + x[j].w * x[j].w);
    const float rs = 1.0f / sqrtf(wave_sum(ss) * (1.0f / D) + RMS_EPS);
#pragma unroll
    for (int j = 0; j < 8; ++j) { const int c = lane + 64 * j;
        const f32x4 gv = ((const f32x4*)g)[c], sv = ((const f32x4*)ms)[c], bv = ((const f32x4*)mb)[c];
        const f32x4 y = (x[j] * rs) * gv * (sv + 1.0f) + bv;
        ((unsigned long long*)orow)[c] = (unsigned long long)pk2(y.x, y.y) | ((unsigned long long)pk2(y.z, y.w) << 32); }
}
__device__ __forceinline__ void resid_norm(f32x4 (&x)[8], const f32x4 (&y)[8], const float* g, const float* mg, int lane) {
    float ss = 0.f;
#pragma unroll
    for (int j = 0; j < 8; ++j) ss += (y[j].x * y[j].x + y[j].y * y[j].y) + (y[j].z * y[j].z + y[j].w * y[j].w);
    const float rs = 1.0f / sqrtf(wave_sum(ss) * (1.0f / D) + RMS_EPS);
#pragma unroll
    for (int j = 0; j < 8; ++j) { const int c = lane + 64 * j; const f32x4 gv = ((const f32x4*)g)[c], mv = ((const f32x4*)mg)[c]; x[j] = x[j] + mv * ((y[j] * rs) * gv); }
}

#define WSP(T, off) ((T*)(ap->ws + (off)))
__device__ __forceinline__ int fresh_lane() { int t = threadIdx.x; asm volatile("" : "+v"(t)); return t & 63; }
__global__ void __launch_bounds__(NWAVES * 64, 2) fwd(Args args_unused) {
    extern __shared__ __attribute__((aligned(16))) unsigned char lds_raw[];
    LAS unsigned char* lds = (LAS unsigned char*)lds_raw;
    const int tid = threadIdx.x, wave = __builtin_amdgcn_readfirstlane(tid >> 6);
    const int G = gridDim.x, gw = blockIdx.x * NWAVES + wave, NGW = G * NWAVES;
    volatile LAS unsigned* MISC = (volatile LAS unsigned*)(lds + MISC_OFF);
    for (int u = tid; u < (LDS_BYTES - RING_BYTES) / 4; u += NWAVES * 64) ((LAS unsigned*)(lds + RING_BYTES))[u] = 0u;
    __syncthreads();
    XcdBarrier bar;
    { ArgsP ap = get_args(); bar = xcd_barrier_post(WSP(unsigned, WS_CTL) + CW_BAR, MISC + 8); }
    LAS unsigned char* wlds = lds + wave * 16384;

    {
        for (int it = gw; it < DEPTH * 8 * 48; it += NGW) {
            ArgsP ap = get_args(); const int lane = fresh_lane();
            const int cb = it % 48, ks = (it / 48) % 8, l = it / (48 * 8);
            LAS float* sil = (LAS float*)wlds;
            const float* cc = ap->in[5]; const float* cx = ap->in[6];
#pragma unroll
            for (int j = 0; j < 4; ++j) { const int k = 256 * ks + lane + 64 * j;
                const float c0 = cx[k], c1 = cc[k], c2 = cc[D + k];
                sil[lane + 64 * j] = c0 / (1.0f + __expf(-c0)); sil[256 + lane + 64 * j] = c1 / (1.0f + __expf(-c1)); sil[512 + lane + 64 * j] = c2 / (1.0f + __expf(-c2)); }
            LDS_WAIT(); asm volatile("" ::: "memory");
            const float* W = ap->in[7] + ((size_t)l * D + 256 * ks) * 12288 + 256 * cb + 4 * lane;
            f32x4 a0 = {0.f, 0.f, 0.f, 0.f}, a1 = a0, a2 = a0;
#pragma unroll 8
            for (int k = 0; k < 256; ++k) { const f32x4 w = *(const f32x4*)(W + (size_t)k * 12288); a0 += w * sil[k]; a1 += w * sil[256 + k]; a2 += w * sil[512 + k]; }
            float* dst = WSP(float, WS_MODP) + ((size_t)(ks * 4 + l) * 3) * 12288 + 256 * cb + 4 * lane;
            *(f32x4*)dst = a0; *(f32x4*)(dst + 12288) = a1; *(f32x4*)(dst + 2 * 12288) = a2;
            LDS_WAIT(); asm volatile("" ::: "memory");
        }
        {
            LAS float* scr = (LAS float*)wlds;
            constexpr int I_IN = (D / 64) * (NIN / 32), I_OUT = (D / 64) * (D / 32), I_1 = (D / 64) * (FF / 32), I_2 = (FF / 64) * (D / 32), I_L = I_IN + I_OUT + I_1 + I_2;
            for (int it = gw; it < DEPTH * I_L; it += NGW) {
                ArgsP ap = get_args(); const int lane = fresh_lane();
                const int l = it / I_L; int r = it % I_L;
                if (r < I_IN) { p0_transpose_item(ap->in[10] + (size_t)l * D * NIN, D, NIN, WSP(bf16, WS_WIN) + (size_t)l * NIN * D, 0, scr, r, lane); continue; } r -= I_IN;
                if (r < I_OUT) { p0_transpose_item(ap->in[16] + (size_t)l * D * D, D, D, WSP(bf16, WS_WOUT) + (size_t)l * D * D, 0, scr, r, lane); continue; } r -= I_OUT;
                if (r < I_1) { p0_transpose_item(ap->in[17] + (size_t)l * D * FF, D, FF, WSP(bf16, WS_W1) + (size_t)l * FF * D, 0, scr, r, lane); continue; } r -= I_1;
                p0_transpose_item(ap->in[18] + (size_t)l * FF * D, FF, D, WSP(bf16, WS_W2) + (size_t)l * D * FF, 0, scr, r, lane);
            }
        }
        {
            ArgsP ap = get_args();
            const size_t gt = (size_t)blockIdx.x * (NWAVES * 64) + tid, NT = (size_t)G * NWAVES * 64;
            for (int which = 0; which < 3; ++which) {
                const float* src = ap->in[2 + which]; bf16* dst = which == 0 ? WSP(bf16, WS_CNA) : (which == 1 ? WSP(bf16, WS_CSWA) : WSP(bf16, WS_CDIFF));
                const size_t n8 = (which == 1 ? (size_t)2 * 4 * 2 * 256 * 128 : (size_t)2 * 4 * 2 * 256 * 512) / 8;
                for (size_t i = gt; i < n8; i += NT) { const f32x4 a = ((const f32x4*)src)[2 * i], b = ((const f32x4*)src)[2 * i + 1];
                    v4u o; o.x = pk2(a.x, a.y); o.y = pk2(a.z, a.w); o.z = pk2(b.x, b.y); o.w = pk2(b.z, b.w); ((v4u*)dst)[i] = o; }
            }
        }
        if (blockIdx.x == 0) { ArgsP ap = get_args(); float* rope_c = WSP(float, WS_ROPE);
            for (int e = tid; e < 1024; e += NWAVES * 64) { const int pos = e >> 4, j = e & 15;
                const double inv = exp(-(double)j * (9.210340371976184 / 16.0)); const double ang = (double)pos * inv;
                rope_c[e] = (float)cos(ang); rope_c[1024 + e] = (float)sin(ang); } }
    }
    xcd_barrier(bar);
    {
        ArgsP ap = get_args();
        const float* MODP = WSP(float, WS_MODP); float* MOD = WSP(float, WS_MOD); const float* ab = ap->in[8];
        const size_t gt = (size_t)blockIdx.x * (NWAVES * 64) + tid, NT = (size_t)G * NWAVES * 64;
        for (size_t i = gt; i < (size_t)DEPTH * 3 * 12288; i += NT) { const int n = (int)(i % 12288); const int lv = (int)(i / 12288); const int l = lv / 3;
            float s = ab[(size_t)l * 12288 + n];
#pragma unroll
            for (int ks = 0; ks < 8; ++ks) s += MODP[(size_t)ks * (4 * 3 * 12288) + i];
            MOD[i] = s; }
    }
    xcd_barrier(bar);
    {
        ArgsP ap = get_args(); const int lane = fresh_lane();
        const float* xp = ap->in[0]; const float* xs = ap->in[1]; const float* g0 = ap->in[9]; const float* MOD = WSP(float, WS_MOD); bf16* Hb = WSP(bf16, WS_H);
        for (int row = gw; row < NTOK; row += NGW) {
            const float* xr = row < NCTX ? xp + (size_t)row * D : xs + (size_t)(row - NCTX) * D;
            f32x4 x[8];
#pragma unroll
            for (int j = 0; j < 8; ++j) x[j] = ((const f32x4*)xr)[lane + 64 * j];
            const int v = row_vec(row);
            norm_mod_store(x, g0, mod_row(MOD, 0, v, 1), mod_row(MOD, 0, v, 0), Hb + (size_t)row * D, lane);
        }
    }
    xcd_barrier(bar);

    for (int l = 0; l < DEPTH; ++l) {
        {
            ArgsP ap = get_args();
            pg8::Gemm g{WSP(bf16, WS_H), WSP(bf16, WS_WIN) + (size_t)l * NIN * D, NTOK, NIN, D}; pg8::StaticOrder S; S.init(NTOK, NIN, G, (int)blockIdx.x);
            float* out = ap->out; float* rope_c = WSP(float, WS_ROPE);
            pg8::EpiIn E{WSP(bf16, WS_P), out + OUT_NA, out + OUT_SWA, out + OUT_DIFF, rope_c, rope_c + 1024, l};
            pg8::gemm_phase<pg8::EpiIn, pg8::StaticOrder, true, true>(lds, g, S, E);
        }
        xcd_barrier(bar);
        {
            ArgsP ap = get_args(); const int lane = fresh_lane();
            mx::MixArgs A{WSP(bf16, WS_P), WSP(bf16, WS_MIX), WSP(bf16, WS_CNA), WSP(bf16, WS_CSWA), WSP(bf16, WS_CDIFF), ap->in[11] + (size_t)l * 3 * 512, ap->in[12] + (size_t)l * 8 * 465, ap->in[13] + l * 8, WSP(float, WS_DP), WSP(float, WS_DS), l};
            unsigned* qh = WSP(unsigned, WS_CTL) + CW_Q + 64 * l;
            LAS float* aux = (LAS float*)(lds + AUX_OFF + wave * AUX_BYTES);
            for (;;) {
                unsigned u = 0; if (lane == 0) u = __hip_atomic_fetch_add(qh, 1u, __ATOMIC_RELAXED, __HIP_MEMORY_SCOPE_AGENT);
                u = (unsigned)__builtin_amdgcn_readfirstlane((int)u);
                if (u >= (unsigned)mx::NUNITS) break;
                mx::mix_unit(A, (int)u, wlds, aux, lane);
            }
        }
        xcd_barrier(bar);
        {
            ArgsP ap = get_args(); const int lane = fresh_lane();
            const float* dl = ap->in[14] + l * 256; const float li = ap->lam_init[l];
            const float lam = __expf(wave_sum(dl[lane] * dl[64 + lane])) - __expf(wave_sum(dl[128 + lane] * dl[192 + lane])) + li;
            const float* DP = WSP(float, WS_DP); const float* DS = WSP(float, WS_DS); bf16* MIXb = WSP(bf16, WS_MIX); const float* dg = ap->in[15] + l * 128;
            for (int row = gw; row < NTOK; row += NGW) mx::diff_combine(DP, DS, MIXb, dg, lam, 1.0f - li, row, lane);
        }
        xcd_barrier(bar);
        {
            ArgsP ap = get_args();
            pg8::Gemm g{WSP(bf16, WS_MIX), WSP(bf16, WS_WOUT) + (size_t)l * D * D, NTOK, D, D}; pg8::StaticOrder S; S.init(NTOK, D, G, (int)blockIdx.x);
            pg8::EpiF32 E{WSP(float, WS_Y), D};
            pg8::gemm_phase<pg8::EpiF32, pg8::StaticOrder, true, true>(lds, g, S, E);
        }
        xcd_barrier(bar);
        {
            ArgsP ap = get_args(); const int lane = fresh_lane();
            float* out = ap->out; const float* xp = (l == 0) ? ap->in[0] : out; const float* xs = (l == 0) ? ap->in[1] : out + (size_t)NCTX * D;
            const float* ng = ap->in[9] + (size_t)l * 4 * D; const float* MOD = WSP(float, WS_MOD); bf16* Hb = WSP(bf16, WS_H); const float* Yb = WSP(float, WS_Y);
            for (int row = gw; row < NTOK; row += NGW) {
                const float* xr = row < NCTX ? xp + (size_t)row * D : xs + (size_t)(row - NCTX) * D;
                f32x4 x[8], y[8];
#pragma unroll
                for (int j = 0; j < 8; ++j) { x[j] = ((const f32x4*)xr)[lane + 64 * j]; y[j] = ((const f32x4*)(Yb + (size_t)row * D))[lane + 64 * j]; }
                const int v = row_vec(row);
                resid_norm(x, y, ng + 1 * D, mod_row(MOD, l, v, 2), lane);
#pragma unroll
                for (int j = 0; j < 8; ++j) ((f32x4*)(out + (size_t)row * D))[lane + 64 * j] = x[j];
                norm_mod_store(x, ng + 2 * D, mod_row(MOD, l, v, 4), mod_row(MOD, l, v, 3), Hb + (size_t)row * D, lane);
            }
        }
        xcd_barrier(bar);
        {
            ArgsP ap = get_args();
            pg8::Gemm g{WSP(bf16, WS_H), WSP(bf16, WS_W1) + (size_t)l * FF * D, NTOK, FF, D}; pg8::StaticOrder S; S.init(NTOK, FF, G, (int)blockIdx.x);
            pg8::EpiRelu2 E{WSP(bf16, WS_F), FF};
            pg8::gemm_phase<pg8::EpiRelu2, pg8::StaticOrder, true, true>(lds, g, S, E);
        }
        xcd_barrier(bar);
        {
            ArgsP ap = get_args();
            pg8::Gemm g{WSP(bf16, WS_F), WSP(bf16, WS_W2) + (size_t)l * D * FF, NTOK, D, FF}; pg8::StaticOrder S; S.init(NTOK, D, G, (int)blockIdx.x);
            pg8::EpiF32 E{WSP(float, WS_Y), D};
            pg8::gemm_phase<pg8::EpiF32, pg8::StaticOrder, true, true>(lds, g, S, E);
        }
        xcd_barrier(bar);
        {
            ArgsP ap = get_args(); const int lane = fresh_lane();
            float* out = ap->out; const float* ng = ap->in[9] + (size_t)l * 4 * D; const float* MOD = WSP(float, WS_MOD); bf16* Hb = WSP(bf16, WS_H); const float* Yb = WSP(float, WS_Y);
            for (int row = gw; row < NTOK; row += NGW) {
                f32x4 x[8], y[8];
#pragma unroll
                for (int j = 0; j < 8; ++j) { x[j] = ((const f32x4*)(out + (size_t)row * D))[lane + 64 * j]; y[j] = ((const f32x4*)(Yb + (size_t)row * D))[lane + 64 * j]; }
                const int v = row_vec(row);
                resid_norm(x, y, ng + 3 * D, mod_row(MOD, l, v, 5), lane);
#pragma unroll
                for (int j = 0; j < 8; ++j) ((f32x4*)(out + (size_t)row * D))[lane + 64 * j] = x[j];
                if (l + 1 < DEPTH) norm_mod_store(x, ng + 4 * D, mod_row(MOD, l + 1, v, 1), mod_row(MOD, l + 1, v, 0), Hb + (size_t)row * D, lane);
            }
        }
        if (l + 1 < DEPTH) xcd_barrier(bar);
    }
}

extern "C" void kernel_launch(void* const* d_in, const int* in_sizes, int n_in, void* d_out, int out_size, void* d_ws, size_t ws_size, hipStream_t stream) {
    static int grid = 0;
    if (grid == 0) {
        if (n_in != 19 || (size_t)out_size != OUT_TOTAL || ws_size < WS_END) { fprintf(stderr, "kernel_launch: unexpected shapes: n_in %d out %d ws %zu\n", n_in, out_size, ws_size); grid = -1; return; }
        int dev = 0, cus = 0, per_cu = 0;
        if (hipGetDevice(&dev) != hipSuccess || hipDeviceGetAttribute(&cus, hipDeviceAttributeMultiprocessorCount, dev) != hipSuccess) { grid = -1; return; }
        if (hipFuncSetAttribute((const void*)fwd, hipFuncAttributeMaxDynamicSharedMemorySize, LDS_BYTES) != hipSuccess) { fprintf(stderr, "kernel_launch: hipFuncSetAttribute failed\n"); grid = -1; return; }
        if (hipOccupancyMaxActiveBlocksPerMultiprocessor(&per_cu, (const void*)fwd, NWAVES * 64, LDS_BYTES) != hipSuccess || per_cu < 1) { fprintf(stderr, "kernel_launch: occupancy query says %d blocks per CU\n", per_cu); }
        (void)hipGetLastError();
        grid = cus;
    }
    if (grid < 0) return;
    if (hipMemsetAsync((char*)d_ws + WS_CTL, 0, CTL_ZERO_BYTES, stream) != hipSuccess) { fprintf(stderr, "kernel_launch: memset failed\n"); return; }
    Args a{};
    for (int i = 0; i < 19; ++i) a.in[i] = (const float*)d_in[i];
    a.out = (float*)d_out; a.ws = (unsigned char*)d_ws;
    for (int l = 0; l < 4; ++l) a.lam_init[l] = (float)(0.8 - 0.6 * exp(-0.3 * (double)l));
    hipLaunchKernelGGL(fwd, dim3(grid), dim3(NWAVES * 64), LDS_BYTES, stream, a);
    const hipError_t le = hipPeekAtLastError();
    if (le != hipSuccess) fprintf(stderr, "kernel_launch: launch failed: %s\n", hipGetErrorName(le));
}
```
